# Optimizing an MI355X kernel written in HIP

```python
import jax, jax.numpy as jnp
from jax import lax
import numpy as np

D_MODEL = 1024
BATCH = 8
SEQ = 4096
DEPTH = 4

N_HEADS = 16
HEAD_DIM = D_MODEL // N_HEADS
D_FF = 2816
CHUNK = 64
LEFT_CHUNKS = 8
BAND = (LEFT_CHUNKS + 1) * CHUNK
REL_CLIP = 256
N_REL = 2 * REL_CLIP + 1
Q_BLOCK = 128
N_A = DEPTH // 2
N_B = DEPTH - N_A
EPS = 1e-6
NEG_INF = -1e30
ATTN_SCALE = HEAD_DIM ** -0.5
FFN_RES_WEIGHT = 0.5

kernel_name = "yoco_chunked_relpos_fox_macaron"


def rms_norm(x, g):
    xf = x.astype(jnp.float32)
    y = xf * lax.rsqrt(jnp.mean(xf * xf, axis=-1, keepdims=True) + EPS)
    return (y * g.astype(jnp.float32)).astype(x.dtype)


def swiglu(x, w_gate, w_up, w_down):
    return (jax.nn.silu(x @ w_gate) * (x @ w_up)) @ w_down


def chunked_relpos_attention(hn, w_qkv, w_o, rel_bias):
    b, s, _ = hn.shape
    nc = s // CHUNK
    q, k, v = jnp.split(hn @ w_qkv, 3, axis=-1)
    q = q.reshape(b, nc, CHUNK, N_HEADS, HEAD_DIM)
    k = k.reshape(b, nc, CHUNK, N_HEADS, HEAD_DIM)
    v = v.reshape(b, nc, CHUNK, N_HEADS, HEAD_DIM)

    def gather_band(t):
        tp = jnp.pad(t, ((0, 0), (LEFT_CHUNKS, 0), (0, 0), (0, 0), (0, 0)))
        return jnp.concatenate([tp[:, j:j + nc] for j in range(LEFT_CHUNKS + 1)], axis=2)

    kb, vb = gather_band(k), gather_band(v)
    qi = jnp.arange(CHUNK)[:, None]
    kj = jnp.arange(BAND)[None, :]
    rel = LEFT_CHUNKS * CHUNK + qi - kj
    rel_idx = jnp.clip(rel, -REL_CLIP, REL_CLIP) + REL_CLIP
    bias = rel_bias[:, rel_idx].astype(jnp.float32)
    key_chunk = jnp.arange(nc)[:, None] - LEFT_CHUNKS + jnp.arange(BAND)[None, :] // CHUNK
    valid = key_chunk >= 0

    logits = jnp.einsum('bcqhd,bckhd->bhcqk', q, kb).astype(jnp.float32) * ATTN_SCALE
    logits = jnp.where(valid[None, None, :, None, :], logits + bias[:, None], NEG_INF)
    p = jax.nn.softmax(logits, axis=-1).astype(vb.dtype)
    o = jnp.einsum('bhcqk,bckhd->bcqhd', p, vb).reshape(b, s, D_MODEL)
    return o @ w_o


def shared_kv_forget(h, kv_norm, w_kvf, b_f):
    b, s, _ = h.shape
    kvf = rms_norm(h, kv_norm) @ w_kvf
    k = kvf[..., :D_MODEL].reshape(b, s, N_HEADS, HEAD_DIM)
    v = kvf[..., D_MODEL:2 * D_MODEL].reshape(b, s, N_HEADS, HEAD_DIM)
    log_f = jax.nn.log_sigmoid(kvf[..., 2 * D_MODEL:].astype(jnp.float32) + b_f.astype(jnp.float32))
    cum_log_f = jnp.cumsum(log_f, axis=1).transpose(0, 2, 1)
    return k, v, cum_log_f


def forgetting_attention(hn, w_q, w_o, k, v, cum_log_f):
    b, s, _ = hn.shape
    q = (hn @ w_q).reshape(b, s, N_HEADS, HEAD_DIM)
    outs = []
    for blk in range(s // Q_BLOCK):
        q0, q1 = blk * Q_BLOCK, (blk + 1) * Q_BLOCK
        logits = jnp.einsum('bqhd,bkhd->bhqk', q[:, q0:q1], k[:, :q1]).astype(jnp.float32) * ATTN_SCALE
        decay = cum_log_f[:, :, q0:q1, None] - cum_log_f[:, :, None, :q1]
        causal = (q0 + jnp.arange(Q_BLOCK))[:, None] >= jnp.arange(q1)[None, :]
        logits = jnp.where(causal, logits + decay, NEG_INF)
        p = jax.nn.softmax(logits, axis=-1).astype(v.dtype)
        outs.append(jnp.einsum('bhqk,bkhd->bqhd', p, v[:, :q1]))
    o = jnp.concatenate(outs, axis=1).reshape(b, s, D_MODEL)
    return o @ w_o


def setup_inputs(seed: int = 0) -> dict:
    key = jax.random.key(seed)
    ks = jax.random.split(key, 16)
    f32 = jnp.float32
    nrm = lambda k, shape, fan_in: jax.random.normal(k, shape, f32) * (fan_in ** -0.5)
    return {
        "x": jax.random.normal(ks[0], (BATCH, SEQ, D_MODEL), f32),
        "ffn_norm": 1.0 + 0.05 * jax.random.normal(ks[1], (DEPTH, 2, D_MODEL), f32),
        "ffn_w_gate": nrm(ks[2], (DEPTH, 2, D_MODEL, D_FF), D_MODEL),
        "ffn_w_up": nrm(ks[3], (DEPTH, 2, D_MODEL, D_FF), D_MODEL),
        "ffn_w_down": nrm(ks[4], (DEPTH, 2, D_FF, D_MODEL), D_FF),
        "mix_norm": 1.0 + 0.05 * jax.random.normal(ks[5], (DEPTH, D_MODEL), f32),
        "a_w_qkv": nrm(ks[6], (N_A, D_MODEL, 3 * D_MODEL), D_MODEL),
        "a_w_o": nrm(ks[7], (N_A, D_MODEL, D_MODEL), D_MODEL),
        "a_rel_bias": 0.5 * jax.random.normal(ks[8], (N_A, N_HEADS, N_REL), f32),
        "kv_norm": 1.0 + 0.05 * jax.random.normal(ks[9], (D_MODEL,), f32),
        "b_w_kvf": nrm(ks[10], (D_MODEL, 2 * D_MODEL + N_HEADS), D_MODEL),
        "b_f_bias": 2.0 + 0.5 * jax.random.normal(ks[11], (N_HEADS,), f32),
        "b_w_q": nrm(ks[12], (N_B, D_MODEL, D_MODEL), D_MODEL),
        "b_w_o": nrm(ks[13], (N_B, D_MODEL, D_MODEL), D_MODEL),
        "final_norm": 1.0 + 0.05 * jax.random.normal(ks[14], (D_MODEL,), f32),
    }


def reference(x, ffn_norm, ffn_w_gate, ffn_w_up, ffn_w_down, mix_norm, a_w_qkv, a_w_o,
              a_rel_bias, kv_norm, b_w_kvf, b_f_bias, b_w_q, b_w_o, final_norm):
    def half_ffn(h, layer, pos):
        hn = rms_norm(h, ffn_norm[layer, pos])
        return h + FFN_RES_WEIGHT * swiglu(hn, ffn_w_gate[layer, pos], ffn_w_up[layer, pos],
                                           ffn_w_down[layer, pos])

    h = x
    for layer in range(N_A):
        h = half_ffn(h, layer, 0)
        h = h + chunked_relpos_attention(rms_norm(h, mix_norm[layer]), a_w_qkv[layer],
                                         a_w_o[layer], a_rel_bias[layer])
        h = half_ffn(h, layer, 1)

    k_sh, v_sh, cum_log_f = shared_kv_forget(h, kv_norm, b_w_kvf, b_f_bias)

    for lb in range(N_B):
        layer = N_A + lb
        h = half_ffn(h, layer, 0)
        h = h + forgetting_attention(rms_norm(h, mix_norm[layer]), b_w_q[lb], b_w_o[lb],
                                     k_sh, v_sh, cum_log_f)
        h = half_ffn(h, layer, 1)

    return rms_norm(h, final_norm)
```

```cpp
#include <hip/hip_runtime.h>
#include <hip/hip_cooperative_groups.h>
#include <cstdio>
#include <cstdint>
namespace cg = cooperative_groups;

#define LAS __attribute__((address_space(3)))
typedef unsigned short bf16_t;
typedef short bf16x8 __attribute__((ext_vector_type(8)));
typedef short s16x4 __attribute__((ext_vector_type(4)));
typedef float f32x4 __attribute__((ext_vector_type(4)));
typedef float f32x16 __attribute__((ext_vector_type(16)));
typedef unsigned u32x4 __attribute__((ext_vector_type(4)));
typedef unsigned u32x2 __attribute__((ext_vector_type(2)));
typedef _Float16 f16x8 __attribute__((ext_vector_type(8)));
typedef _Float16 f16x2 __attribute__((ext_vector_type(2)));
__device__ __forceinline__ unsigned pack_h2(float a, float b) { const f16x2 v = {(_Float16)a, (_Float16)b}; return __builtin_bit_cast(unsigned, v); }
__device__ __forceinline__ float h_lo(unsigned w) { return (float)__builtin_bit_cast(f16x2, w).x; }
__device__ __forceinline__ float h_hi(unsigned w) { return (float)__builtin_bit_cast(f16x2, w).y; }

constexpr int BATCH = 8, SEQ = 4096, DM = 1024, NH = 16, HD = 64, FF = 2816, TOK = BATCH * SEQ, NREL = 513;
constexpr float EPS = 1e-6f;
constexpr float LOG2E = 1.4426950408889634f;
constexpr float QSCALE = 0.125f * LOG2E;

constexpr size_t MiB = 1u << 20;
constexpr size_t WS_SSQ = 0;
constexpr size_t WS_FLOG = 2 * MiB;
constexpr size_t WS_CUM = 4 * MiB;
constexpr size_t WS_BAR = 6 * MiB;
constexpr size_t WS_W = 8 * MiB;
constexpr size_t W_FFN_BLK = (size_t)(2 * FF * DM + DM * FF) * 2;
constexpr size_t W_GU_BYTES = (size_t)2 * FF * DM * 2;
constexpr size_t WS_WQKV = WS_W + 8 * W_FFN_BLK;
constexpr size_t WS_WAO = WS_WQKV + 2 * (size_t)3 * DM * DM * 2;
constexpr size_t WS_WKVF = WS_WAO + 2 * (size_t)DM * DM * 2;
constexpr size_t WS_WBQ = WS_WKVF + (size_t)2304 * DM * 2;
constexpr size_t WS_WBO = WS_WBQ + 2 * (size_t)DM * DM * 2;
constexpr size_t WS_WEND = WS_WBO + 2 * (size_t)DM * DM * 2;
constexpr size_t WS_HB = 169 * MiB;
constexpr size_t WS_R = 233 * MiB;
constexpr size_t WS_VSH = 425 * MiB;
constexpr size_t WS_KSH = WS_W;
constexpr size_t WS_END = 489 * MiB;
static_assert(WS_WEND <= WS_HB, "weights overflow");
static_assert(4 * W_FFN_BLK >= (size_t)TOK * DM * 2, "K_sh overlay must fit in the layer 0/1 FFN weights");
static_assert((size_t)SEQ * FF * 2 <= 24 * MiB && 3 * (size_t)SEQ * DM * 2 <= 24 * MiB && 8 * 24 * MiB <= WS_VSH - WS_R, "per-batch regions fit R");

namespace pg8 {
constexpr int BM = 256, BK = 64, HALF = 128, HTB = HALF * BK * 2, STAGE_BYTES = 8 * HTB, NXCD = 8, WGM = 4;
__host__ __device__ __forceinline__ int lds_byte(int r, int c) { const int st = (r >> 4) * 2 + (c >> 5), rr = r & 15, cc = c & 31, ob = rr * 64 + cc * 2; return st * 1024 + (ob ^ (((ob >> 9) & 1) << 5)); }
__host__ __device__ __forceinline__ void stage_rc(int b, int& R, int& C) { const int st = b / 1024, sb = b % 1024, swz = sb ^ (((sb >> 9) & 1) << 5); R = (st >> 1) * 16 + swz / 64; C = (st & 1) * 32 + (swz % 64) / 2; }
__host__ __device__ __forceinline__ int perm32(int rho) { const int n = rho >> 4, i = rho & 15; return 8 * (i >> 2) + 4 * n + (i & 3); }

struct Unit { int pm, pn; };
struct Gemm { const bf16_t* A; const bf16_t* Bt; int M, N, K; };

struct StaticOrder {
    int nM, nN, nwg, G, c;
    __host__ __device__ void init(int M, int N, int G_, int c_) { nM = M / BM; nN = N / BM; nwg = nM * nN; G = G_; c = c_; }
    __host__ __device__ bool next(int i, Unit& u) const {
        const long L = (long)i * G + c; if (L >= nwg) return false;
        int wgid = (int)L; { const int q = nwg / NXCD, r = nwg % NXCD, xcd = wgid % NXCD, off = wgid / NXCD; wgid = (xcd < r ? xcd * (q + 1) : r * (q + 1) + (xcd - r) * q) + off; }
        const int nig = WGM * nN, gid = wgid / nig, fm = gid * WGM, gsz = (nM - fm) < WGM ? (nM - fm) : WGM;
        u.pm = fm + ((wgid % nig) % gsz); u.pn = (wgid % nig) / gsz; return true;
    }
    __device__ __forceinline__ void a_ready(const Unit&) const {}
    __device__ __forceinline__ void done(const Unit&) const {}
};

__device__ __forceinline__ unsigned cvt_pk_bf16(float lo, float hi) { unsigned r; asm volatile("v_cvt_pk_bf16_f32 %0, %1, %2" : "=v"(r) : "v"(lo), "v"(hi)); return r; }

__device__ __forceinline__ float fq_sum(float v) {
    auto a = __builtin_amdgcn_permlane16_swap(__float_as_uint(v), __float_as_uint(v), false, false); v = __uint_as_float(a[0]) + __uint_as_float(a[1]);
    auto b = __builtin_amdgcn_permlane32_swap(__float_as_uint(v), __float_as_uint(v), false, false); return __uint_as_float(b[0]) + __uint_as_float(b[1]);
}
#define GAS __attribute__((address_space(1)))
__device__ __forceinline__ float fmul_s(float a, float b) { float r; asm("v_mul_f32_e32 %0, %1, %2" : "=v"(r) : "v"(a), "v"(b)); return r; }
__device__ __forceinline__ float row_rstd(const GAS float* ssq, int row, int fq) {
    const f32x4 pp = *(const GAS f32x4*)(ssq + (size_t)row * 16 + 4 * fq);
    const float s = fq_sum((pp.x + pp.y) + (pp.z + pp.w));
    return __builtin_amdgcn_rsqf(s * (1.0f / DM) + EPS);
}

struct EpiSwiglu {
    static constexpr bool PERM = true, AFTER_DRAIN = false, F16 = true;
    bf16_t* O; const LAS float* rstd; int rowbase;
    __device__ __forceinline__ void operator()(const f32x4 (&acc)[2][2][4][2], const Unit& u, int wr, int wc, int fr, int fq) const {
        const int row0 = u.pm * BM + wr * 64 + fr, col0 = u.pn * HALF + wc * 32 + 8 * fq;
        GAS bf16_t* O_g = (GAS bf16_t*)O;
        float rs[8];
#pragma unroll
        for (int i = 0; i < 8; ++i) rs[i] = rstd[row0 + (i >> 2) * HALF + (i & 3) * 16 - rowbase];
#pragma unroll
        for (int ai = 0; ai < 2; ++ai)
#pragma unroll
            for (int m = 0; m < 4; ++m) {
                const int row = row0 + ai * HALF + m * 16; const float r = rs[ai * 4 + m], nrl = -r * LOG2E, rs2 = r * r;
                unsigned w[4];
#pragma unroll
                for (int n = 0; n < 2; ++n) {
                    const f32x4 g = acc[ai][0][m][n], up = acc[ai][1][m][n];
                    const f32x4 t = g * nrl; f32x4 ex, sg;
#pragma unroll
                    for (int e = 0; e < 4; ++e) ex[e] = __builtin_amdgcn_exp2f(t[e]);
                    const f32x4 d = ex + 1.0f;
#pragma unroll
                    for (int e = 0; e < 4; ++e) sg[e] = __builtin_amdgcn_rcpf(d[e]);
                    const f32x4 y = (g * up) * (sg * rs2);
                    w[2 * n] = cvt_pk_bf16(y[0], y[1]); w[2 * n + 1] = cvt_pk_bf16(y[2], y[3]);
                }
                *(GAS u32x4*)(O_g + (size_t)row * FF + col0) = (u32x4){w[0], w[1], w[2], w[3]};
            }
    }
};

__device__ __forceinline__ float bf_lo(unsigned w) { return __uint_as_float(w << 16); }
__device__ __forceinline__ float bf_hi(unsigned w) { return __uint_as_float(w & 0xffff0000u); }
struct EpiResid {
    static constexpr bool PERM = true, AFTER_DRAIN = false, F16 = false;
    bf16_t* hb; float* ssq; float alpha;
    __device__ __forceinline__ void operator()(const f32x4 (&acc)[2][2][4][2], const Unit& u, int wr, int wc, int fr, int fq) const {
        const int row0 = u.pm * BM + wr * 64 + fr, col0 = u.pn * BM + wc * 32 + 8 * fq;
        GAS bf16_t* hb_g = (GAS bf16_t*)hb; GAS float* ssq_g = (GAS float*)ssq;
        u32x4 bv[8][2];
#pragma unroll
        for (int q = 0; q < 4; ++q)
#pragma unroll
            for (int bj = 0; bj < 2; ++bj) bv[q][bj] = *(const GAS u32x4*)(hb_g + (size_t)(row0 + (q >> 2) * HALF + (q & 3) * 16) * DM + col0 + bj * HALF);
#pragma unroll
        for (int q = 0; q < 8; ++q) {
            const int ai = q >> 2, m = q & 3;
            const int row = row0 + ai * HALF + m * 16; float ss = 0.f;
#pragma unroll
            for (int bj = 0; bj < 2; ++bj) {
                const size_t off = (size_t)row * DM + col0 + bj * HALF;
                const u32x4 b = bv[q][bj];
                const f32x4 a0 = acc[ai][bj][m][0] * alpha, a1 = acc[ai][bj][m][1] * alpha;
                u32x4 o;
                o.x = pack_h2(h_lo(b.x) + a0[0], h_hi(b.x) + a0[1]); o.y = pack_h2(h_lo(b.y) + a0[2], h_hi(b.y) + a0[3]);
                o.z = pack_h2(h_lo(b.z) + a1[0], h_hi(b.z) + a1[1]); o.w = pack_h2(h_lo(b.w) + a1[2], h_hi(b.w) + a1[3]);
                *(GAS u32x4*)(hb_g + off) = o;
                const float r0 = h_lo(o.x), r1 = h_hi(o.x), r2 = h_lo(o.y), r3 = h_hi(o.y), r4 = h_lo(o.z), r5 = h_hi(o.z), r6 = h_lo(o.w), r7 = h_hi(o.w);
                ss += (r0 * r0 + r1 * r1) + (r2 * r2 + r3 * r3) + (r4 * r4 + r5 * r5) + (r6 * r6 + r7 * r7);
            }
            if (q + 4 < 8) {
#pragma unroll
                for (int bj = 0; bj < 2; ++bj) bv[q + 4][bj] = *(const GAS u32x4*)(hb_g + (size_t)(row0 + ((q + 4) >> 2) * HALF + ((q + 4) & 3) * 16) * DM + col0 + bj * HALF);
            }
            ss = fq_sum(ss);
            if (fq == 0) ssq_g[(size_t)row * 16 + u.pn * 4 + wc] = ss;
        }
    }
};

struct EpiProj {
    static constexpr bool PERM = true, AFTER_DRAIN = false, F16 = true;
    bf16_t* O0; long ostride; const LAS float* rstd; int rowbase; float scale0; float* flog; const float* bf;
    __device__ __forceinline__ void operator()(const f32x4 (&acc)[2][2][4][2], const Unit& u, int wr, int wc, int fr, int fq) const {
        const int row0 = u.pm * BM + wr * 64 + fr; const int t = u.pn >> 2, pnl = u.pn & 3;
        float rs[8];
#pragma unroll
        for (int i = 0; i < 8; ++i) rs[i] = rstd[row0 + (i >> 2) * HALF + (i & 3) * 16 - rowbase];
        if (t == 2 && flog) {
            GAS float* flog_g = (GAS float*)flog; const GAS float* bf_g = (const GAS float*)bf;
            if (wc == 0 && fq < 2) {
                const f32x4 b0 = *(const GAS f32x4*)(bf_g + 8 * fq), b1 = *(const GAS f32x4*)(bf_g + 8 * fq + 4);
#pragma unroll
                for (int ai = 0; ai < 2; ++ai)
#pragma unroll
                    for (int m = 0; m < 4; ++m) {
                        const int row = row0 + ai * HALF + m * 16; const float r = rs[ai * 4 + m]; f32x4 o[2];
#pragma unroll
                        for (int n = 0; n < 2; ++n)
#pragma unroll
                            for (int e = 0; e < 4; ++e) { const float x = acc[ai][0][m][n][e] * r + (n == 0 ? b0[e] : b1[e]);
                                o[n][e] = fminf(x, 0.f) - 0.6931471805599453f * __builtin_amdgcn_logf(1.0f + __builtin_amdgcn_exp2f(-fabsf(x) * LOG2E)); }
                        *(GAS f32x4*)(flog_g + (size_t)row * 16 + 8 * fq) = o[0]; *(GAS f32x4*)(flog_g + (size_t)row * 16 + 8 * fq + 4) = o[1];
                    }
            }
            return;
        }
        GAS bf16_t* O = (GAS bf16_t*)O0 + (long)t * ostride; const float sc = t == 0 ? scale0 : 1.0f;
        const int col0 = pnl * BM + wc * 32 + 8 * fq;
#pragma unroll
        for (int ai = 0; ai < 2; ++ai)
#pragma unroll
            for (int m = 0; m < 4; ++m) {
                const int row = row0 + ai * HALF + m * 16; const float r = rs[ai * 4 + m] * sc;
#pragma unroll
                for (int bj = 0; bj < 2; ++bj) {
                    const f32x4 v0 = acc[ai][bj][m][0] * r, v1 = acc[ai][bj][m][1] * r;
                    *(GAS u32x4*)(O + (size_t)row * DM + col0 + bj * HALF) = (u32x4){cvt_pk_bf16(v0[0], v0[1]), cvt_pk_bf16(v0[2], v0[3]), cvt_pk_bf16(v1[0], v1[1]), cvt_pk_bf16(v1[2], v1[3])};
                }
            }
    }
};

template <class Epi, class Sched, bool ALIGN_EPI = false, bool SP2 = false>
__device__ __forceinline__ void gemm_phase(LAS unsigned char* lds, const Gemm g, const Sched& S, const Epi& E, const int tid) {
    const int wid = __builtin_amdgcn_readfirstlane(tid >> 6), lane = tid & 63, wr = wid >> 2, wc = wid & 3, fr = lane & 15, fq = lane >> 4;
    const int K = g.K, nt = K / BK;
    unsigned voffA[2], voffB[2];
#pragma unroll
    for (int i = 0; i < 2; ++i) { int R, C; stage_rc(tid * 16 + i * 8192, R, C); const int Rb = Epi::PERM ? ((R & ~31) + perm32(R & 31)) : R;
        voffA[i] = (unsigned)(R * K + C) * 2u; voffB[i] = (unsigned)(Rb * K + C) * 2u; }
    const size_t kstep = (size_t)(BK * 2);
    const size_t hstep = (size_t)HALF * K * 2;
    const size_t tstep = 2 * hstep;
    const unsigned ldsw = (unsigned)wid * 1024u;
    const int aoff = lds_byte(wr * 64 + fr, fq * 8), boff = lds_byte(wc * 32 + fr, fq * 8);
#define PG8_SA(b, h) (((b) * 2 + (h)) * HTB)
#define PG8_SB(b, h) ((4 + (b) * 2 + (h)) * HTB)
#define PG8_STAGE(bufoff, gbase, voff) do { _Pragma("unroll") for (int _i = 0; _i < 2; ++_i) \
        __builtin_amdgcn_global_load_lds((const unsigned*)((const char*)(gbase) + (voff)[_i]), (LAS unsigned*)(lds + (bufoff) + ldsw + _i * 8192), 16, 0, 0); } while (0)
#define PG8_LDA(dst, b, h) do { _Pragma("unroll") for (int m = 0; m < 4; ++m) _Pragma("unroll") for (int k = 0; k < 2; ++k) dst[m][k] = *(const LAS bf16x8*)(lds + PG8_SA(b, h) + aoff + m * 2048 + k * 1024); } while (0)
#define PG8_LDB(dst, b, h) do { _Pragma("unroll") for (int n = 0; n < 2; ++n) _Pragma("unroll") for (int k = 0; k < 2; ++k) dst[n][k] = *(const LAS bf16x8*)(lds + PG8_SB(b, h) + boff + n * 2048 + k * 1024); } while (0)
#define PG8_MMA(ai, bj, At, Bt) do { __builtin_amdgcn_s_setprio(1); _Pragma("unroll") for (int m = 0; m < 4; ++m) _Pragma("unroll") for (int n = 0; n < 2; ++n) _Pragma("unroll") for (int k = 0; k < 2; ++k) \
        { if constexpr (Epi::F16) acc[ai][bj][m][n] = __builtin_amdgcn_mfma_f32_16x16x32_f16(__builtin_bit_cast(f16x8, Bt[n][k]), __builtin_bit_cast(f16x8, At[m][k]), acc[ai][bj][m][n], 0, 0, 0); \
          else acc[ai][bj][m][n] = __builtin_amdgcn_mfma_f32_16x16x32_bf16(Bt[n][k], At[m][k], acc[ai][bj][m][n], 0, 0, 0); } __builtin_amdgcn_s_setprio(0); } while (0)
#define PG8_WAIT_V(n) asm volatile("s_waitcnt vmcnt(" #n ")" ::: "memory")
#define PG8_WAIT_L(n) asm volatile("s_waitcnt lgkmcnt(" #n ")" ::: "memory")
#define PG8_BAR __builtin_amdgcn_s_barrier()
#define PG8_SCHED __builtin_amdgcn_sched_barrier(0)
    Unit cur, nxt; int ui = 0;
    if (!S.next(0, cur)) return;
    f32x4 acc[2][2][4][2];
#pragma unroll
    for (int a = 0; a < 2; ++a)
#pragma unroll
        for (int b = 0; b < 2; ++b)
#pragma unroll
            for (int m = 0; m < 4; ++m)
#pragma unroll
                for (int n = 0; n < 2; ++n) acc[a][b][m][n] = (f32x4){0.f, 0.f, 0.f, 0.f};
    bf16x8 At[4][2], B0[2][2], B1[2][2];
    const char* cA = (const char*)g.A + (size_t)cur.pm * tstep; const char* cB = (const char*)g.Bt + (size_t)cur.pn * tstep;
    S.a_ready(cur);
    if constexpr (SP2) {
        PG8_STAGE(PG8_SB(0, 0), cB, voffB); PG8_STAGE(PG8_SB(0, 1), cB + hstep, voffB); PG8_STAGE(PG8_SA(0, 0), cA, voffA); PG8_STAGE(PG8_SA(0, 1), cA + hstep, voffA);
        if (wr == 1) PG8_BAR;
        PG8_WAIT_V(2); PG8_BAR;
        PG8_STAGE(PG8_SB(1, 0), cB + kstep, voffB); PG8_STAGE(PG8_SA(1, 0), cA + kstep, voffA); PG8_STAGE(PG8_SB(1, 1), cB + hstep + kstep, voffB);
        PG8_WAIT_V(6); PG8_BAR;
    } else {
        PG8_STAGE(PG8_SB(0, 0), cB, voffB); PG8_STAGE(PG8_SA(0, 0), cA, voffA); PG8_STAGE(PG8_SB(0, 1), cB + hstep, voffB); PG8_STAGE(PG8_SA(0, 1), cA + hstep, voffA);
        if (wr == 1) PG8_BAR;
        PG8_WAIT_V(4); PG8_BAR;
        PG8_STAGE(PG8_SB(1, 0), cB + kstep, voffB); PG8_STAGE(PG8_SA(1, 0), cA + kstep, voffA); PG8_STAGE(PG8_SB(1, 1), cB + hstep + kstep, voffB);
        PG8_WAIT_V(6); PG8_BAR;
    }
    for (;;) {
        const bool has_next = S.next(ui + 1, nxt);
        const char* nA = has_next ? (const char*)g.A + (size_t)nxt.pm * tstep : cA; const char* nB = has_next ? (const char*)g.Bt + (size_t)nxt.pn * tstep : cB;
        for (int t = 0; t < nt; t += 2) {
            const bool last = (t == nt - 2);
            const char* a1 = cA + (size_t)(t + 1) * kstep;
            const char* a2 = last ? nA : cA + (size_t)(t + 2) * kstep; const char* b2 = last ? nB : cB + (size_t)(t + 2) * kstep;
            const char* a3 = a2 + kstep; const char* b3 = b2 + kstep;
            if (last && has_next) S.a_ready(nxt);
            if constexpr (SP2) {
            PG8_LDB(B0, 0, 0); PG8_LDB(B1, 0, 1); PG8_SCHED; PG8_LDA(At, 0, 0); PG8_STAGE(PG8_SA(1, 1), a1 + hstep, voffA);
            PG8_WAIT_V(8); PG8_WAIT_L(0); PG8_BAR; PG8_MMA(0, 0, At, B0); PG8_MMA(0, 1, At, B1); PG8_BAR; PG8_SCHED;
            PG8_LDA(At, 0, 1); PG8_STAGE(PG8_SB(0, 0), b2, voffB); PG8_STAGE(PG8_SB(0, 1), b2 + hstep, voffB); PG8_STAGE(PG8_SA(0, 0), a2, voffA);
            PG8_WAIT_V(8); PG8_WAIT_L(0); PG8_BAR; PG8_MMA(1, 0, At, B0); PG8_MMA(1, 1, At, B1); PG8_BAR; PG8_SCHED;
            PG8_LDB(B0, 1, 0); PG8_LDB(B1, 1, 1); PG8_SCHED; PG8_LDA(At, 1, 0); PG8_STAGE(PG8_SA(0, 1), a2 + hstep, voffA);
            PG8_WAIT_V(8); PG8_WAIT_L(0); PG8_BAR; PG8_MMA(0, 0, At, B0); PG8_MMA(0, 1, At, B1); PG8_BAR; PG8_SCHED;
            PG8_LDA(At, 1, 1); PG8_STAGE(PG8_SB(1, 0), b3, voffB); PG8_STAGE(PG8_SB(1, 1), b3 + hstep, voffB); PG8_STAGE(PG8_SA(1, 0), a3, voffA);
            PG8_WAIT_V(8); PG8_WAIT_L(0); PG8_BAR; PG8_MMA(1, 0, At, B0); PG8_MMA(1, 1, At, B1); PG8_BAR; PG8_SCHED;
            } else {
            PG8_LDB(B0, 0, 0); PG8_SCHED; PG8_LDA(At, 0, 0); PG8_STAGE(PG8_SA(1, 1), a1 + hstep, voffA);
            PG8_WAIT_L(8); PG8_BAR; PG8_WAIT_L(0); PG8_MMA(0, 0, At, B0); PG8_BAR; PG8_SCHED;
            PG8_LDB(B1, 0, 1); PG8_STAGE(PG8_SB(0, 0), b2, voffB);
            PG8_BAR; PG8_WAIT_L(0); PG8_MMA(0, 1, At, B1); PG8_BAR;
            PG8_LDA(At, 0, 1); PG8_STAGE(PG8_SA(0, 0), a2, voffA);
            PG8_BAR; PG8_WAIT_L(0); PG8_MMA(1, 0, At, B0); PG8_BAR; PG8_SCHED;
            PG8_STAGE(PG8_SB(0, 1), b2 + hstep, voffB);
            PG8_WAIT_V(6); PG8_BAR; PG8_MMA(1, 1, At, B1); PG8_BAR;
            PG8_LDB(B0, 1, 0); PG8_SCHED; PG8_LDA(At, 1, 0); PG8_STAGE(PG8_SA(0, 1), a2 + hstep, voffA);
            PG8_WAIT_L(8); PG8_BAR; PG8_WAIT_L(0); PG8_MMA(0, 0, At, B0); PG8_BAR; PG8_SCHED;
            PG8_LDB(B1, 1, 1); PG8_STAGE(PG8_SB(1, 0), b3, voffB);
            PG8_BAR; PG8_WAIT_L(0); PG8_MMA(0, 1, At, B1); PG8_BAR;
            PG8_LDA(At, 1, 1); PG8_STAGE(PG8_SA(1, 0), a3, voffA);
            PG8_BAR; PG8_WAIT_L(0); PG8_MMA(1, 0, At, B0); PG8_BAR; PG8_SCHED;
            PG8_STAGE(PG8_SB(1, 1), b3 + hstep, voffB);
            PG8_WAIT_V(6); PG8_BAR; PG8_MMA(1, 1, At, B1); PG8_BAR;
            }
        }
        if constexpr (ALIGN_EPI) { if (wr == 0) PG8_BAR; }
        if constexpr (!Epi::AFTER_DRAIN) { E(acc, cur, wr, wc, fr, fq); S.done(cur); }
        if (!has_next) break;
#pragma unroll
        for (int a = 0; a < 2; ++a)
#pragma unroll
            for (int b = 0; b < 2; ++b)
#pragma unroll
                for (int m = 0; m < 4; ++m)
#pragma unroll
                    for (int n = 0; n < 2; ++n) acc[a][b][m][n] = (f32x4){0.f, 0.f, 0.f, 0.f};
        cur = nxt; cA = nA; cB = nB; ++ui;
        if constexpr (ALIGN_EPI) { if (wr == 1) PG8_BAR; }
    }
    PG8_WAIT_V(0);
    if constexpr (!ALIGN_EPI) { if (wr == 0) PG8_BAR; }
    PG8_BAR;
#undef PG8_SA
#undef PG8_SB
#undef PG8_STAGE
#undef PG8_LDA
#undef PG8_LDB
#undef PG8_MMA
#undef PG8_WAIT_V
#undef PG8_WAIT_L
#undef PG8_BAR
#undef PG8_SCHED
}
}

namespace att {
constexpr int L_K = 0, L_V = 40960, L_KB = 81920, L_BIAS = 83200, NTAB = 639, L_END = 83200 + 2560;
__device__ __forceinline__ int crow(int r, int hi) { return (r & 3) + 8 * (r >> 2) + 4 * hi; }
__device__ __forceinline__ unsigned cvtpk(float lo, float hi) { unsigned r; asm volatile("v_cvt_pk_bf16_f32 %0, %1, %2" : "=v"(r) : "v"(lo), "v"(hi)); return r; }
typedef float f32x2_t __attribute__((ext_vector_type(2))); typedef __bf16 bf16x2_t __attribute__((ext_vector_type(2)));
__device__ __forceinline__ unsigned cvtpk_c(float lo, float hi) { const f32x2_t v = {lo, hi}; const bf16x2_t b = __builtin_convertvector(v, bf16x2_t); return __builtin_bit_cast(unsigned, b); }
__device__ __forceinline__ s16x4 vtr(LAS const unsigned char* p) { return __builtin_bit_cast(s16x4, __builtin_amdgcn_ds_read_tr16_b64_v4i16((LAS s16x4*)p)); }

__device__ __forceinline__ float fadd_s(float a, float b) { float r; asm("v_add_f32_e32 %0, %1, %2" : "=v"(r) : "v"(a), "v"(b)); return r; }
__device__ __forceinline__ float fsub_s(float a, float b) { float r; asm("v_sub_f32_e32 %0, %1, %2" : "=v"(r) : "v"(a), "v"(b)); return r; }
__device__ __forceinline__ float fadd_tr(float a, float b) { float r; asm("s_nop 0\n\tv_add_f32_e32 %0, %1, %2" : "=v"(r) : "v"(a), "v"(b)); return r; }
__device__ __forceinline__ unsigned cvtpk_tr(float lo, float hi) { unsigned r; asm volatile("s_nop 0\n\tv_cvt_pk_bf16_f32 %0, %1, %2" : "=v"(r) : "v"(lo), "v"(hi)); return r; }
__device__ __forceinline__ float fadd4_tr(float acc, float a, float b, float c, float d) {
    asm("s_nop 0\n\tv_add_f32_e32 %0, %0, %1\n\tv_add_f32_e32 %0, %0, %2\n\tv_add_f32_e32 %0, %0, %3\n\tv_add_f32_e32 %0, %0, %4" : "+v"(acc) : "v"(a), "v"(b), "v"(c), "v"(d)); return acc; }
__device__ __forceinline__ void cvtpk2_tr(unsigned& r0, unsigned& r1, float a, float b, float c, float d) {
    asm volatile("s_nop 0\n\tv_cvt_pk_bf16_f32 %0, %2, %3\n\tv_cvt_pk_bf16_f32 %1, %4, %5" : "=&v"(r0), "=&v"(r1) : "v"(a), "v"(b), "v"(c), "v"(d)); }
__device__ __forceinline__ float xhalf_max(float v) { auto rr = __builtin_amdgcn_permlane32_swap(__float_as_uint(v), __float_as_uint(v), false, false); return fmaxf(__uint_as_float(rr[0]), __uint_as_float(rr[1])); }
__device__ __forceinline__ float xhalf_sum(float v) { auto rr = __builtin_amdgcn_permlane32_swap(__float_as_uint(v), __float_as_uint(v), false, false); return __uint_as_float(rr[0]) + __uint_as_float(rr[1]); }
__device__ __forceinline__ float ffma_s(float a, float b, float c) { float r; asm("v_fma_f32 %0, %1, %2, %3" : "=v"(r) : "v"(a), "v"(b), "v"(c)); return r; }
__device__ __forceinline__ void glds16(const void* gsrc, unsigned lds_dst) { unsigned keep;
    asm volatile("s_mov_b32 %0, m0\n\ts_mov_b32 m0, %2\n\ts_nop 0\n\tglobal_load_lds_dwordx4 %1, off\n\ts_mov_b32 m0, %0" : "=&s"(keep) : "v"(gsrc), "s"(lds_dst) : "memory"); }
__device__ __forceinline__ void glds4(const void* gsrc, unsigned lds_dst) { unsigned keep;
    asm volatile("s_mov_b32 %0, m0\n\ts_mov_b32 m0, %2\n\ts_nop 0\n\tglobal_load_lds_dword %1, off\n\ts_mov_b32 m0, %0" : "=&s"(keep) : "v"(gsrc), "s"(lds_dst) : "memory"); }
template <int MODE>
__device__ __forceinline__ void attn_unit(LAS unsigned char* lds, const bf16_t* Q, const bf16_t* K, const bf16_t* V, bf16_t* O, const float* aux, int b, int h, int qb, const int tid) {
    const int lane = tid & 63, wid = __builtin_amdgcn_readfirstlane(tid >> 6), r32 = lane & 31, hi = lane >> 5;
    const size_t rowbase = (size_t)b * SEQ; const int q0 = qb * 256;
    const int t_begin = MODE == 0 ? (4 * qb - 8 > 0 ? 4 * qb - 8 : 0) : 0, t_end = 4 * qb + 4, nt = t_end - t_begin;
    const int cq = 4 * qb + (wid >> 1);
    const int w_lo = MODE == 0 ? cq - 8 : 0, w_hi = cq;
    asm volatile("s_waitcnt vmcnt(0)" ::: "memory");
    const bf16_t* ksrc = K + (rowbase + lane) * DM + h * HD + wid * 8;
    const bf16_t* vsrc = V + (rowbase + 16 * (wid & 3) + (lane >> 2)) * DM + h * HD + (wid >> 2) * 32 + (lane & 3) * 8;
    const float* cum = aux + ((size_t)b * NH + h) * SEQ;
    LAS float* biasL = (LAS float*)(lds + L_BIAS);
    if (MODE == 0) { const float* tab = aux + (size_t)h * NREL; for (int i = tid; i < NTAB; i += 512) { int rel = i - 63; rel = rel < -256 ? -256 : (rel > 256 ? 256 : rel); biasL[i] = tab[rel + 256] * LOG2E; } }
    bf16x8 qr[4];
    { const bf16_t* Qw = Q + (rowbase + q0 + wid * 32 + r32) * DM + h * HD + hi * 8;
#pragma unroll
      for (int s = 0; s < 4; ++s) qr[s] = *(const bf16x8*)(Qw + s * 16); }
    float beta = 0.f;
    if (MODE == 1) beta = __builtin_bit_cast(float, __builtin_amdgcn_readfirstlane(__builtin_bit_cast(int, cum[q0 + 32 * wid + 31] * (-LOG2E))));
    const unsigned lds0 = (unsigned)(uintptr_t)lds;
    const unsigned kdst = lds0 + L_K + wid * 1024, vdst = lds0 + L_V + wid * 1024, bdst = lds0 + L_KB;
    const bool w0 = (MODE == 1) && (wid == 0);
#define ATT_DMA(tt, slot) do { glds16(ksrc + (size_t)(tt) * 64 * DM, (unsigned)__builtin_amdgcn_readfirstlane(kdst + (slot) * 8192)); \
        glds16(vsrc + (size_t)(tt) * 64 * DM, (unsigned)__builtin_amdgcn_readfirstlane(vdst + (slot) * 8192)); \
        if (w0) glds4(cum + (tt) * 64 + lane, (unsigned)__builtin_amdgcn_readfirstlane(bdst + (slot) * 256)); } while (0)
#define ATT_WAITB(n) do { const int n_ = (n); \
        if (w0) { if (n_ >= 2) asm volatile("s_waitcnt vmcnt(6) lgkmcnt(0)\n\ts_barrier" ::: "memory"); else if (n_ == 1) asm volatile("s_waitcnt vmcnt(3) lgkmcnt(0)\n\ts_barrier" ::: "memory"); else asm volatile("s_waitcnt vmcnt(0) lgkmcnt(0)\n\ts_barrier" ::: "memory"); } \
        else    { if (n_ >= 2) asm volatile("s_waitcnt vmcnt(4) lgkmcnt(0)\n\ts_barrier" ::: "memory"); else if (n_ == 1) asm volatile("s_waitcnt vmcnt(2) lgkmcnt(0)\n\ts_barrier" ::: "memory"); else asm volatile("s_waitcnt vmcnt(0) lgkmcnt(0)\n\ts_barrier" ::: "memory"); } } while (0)
#pragma unroll
    for (int k = 0; k < 4; ++k) if (k < nt) ATT_DMA(t_begin + k, k);
    ATT_WAITB(nt - 2 > 2 ? 2 : (nt - 2 < 0 ? 0 : nt - 2));
    const unsigned kfoff = hi * 1024 + r32 * 16;
    bf16x8 kf[8];
#pragma unroll
    for (int s = 0; s < 4; ++s) { kf[2 * s] = *(LAS const bf16x8*)(lds + L_K + kfoff + s * 2048); kf[2 * s + 1] = *(LAS const bf16x8*)(lds + L_K + kfoff + s * 2048 + 512); }
    float mu = 0.f, lrun = 0.f; f32x16 o0 = {}, o1 = {};
    const int qpos = q0 + wid * 32 + r32;
    const int vlane = ((lane >> 4) & 1) * 32 + (lane & 3) * 8 + (4 * hi + ((lane & 15) >> 2)) * 64;
    constexpr float THR = 12.0f;
    int cur = 0;
    for (int i = 0; i < nt; ++i) {
        const int t = t_begin + i; const int nxt = cur == 4 ? 0 : cur + 1, s4 = cur == 0 ? 4 : cur - 1;
        if (i + 4 < nt) ATT_DMA(t + 4, s4);
        const bool act = (t >= w_lo && t <= w_hi);
        f32x16 p0, p1; s16x4 vf[16];
        if (act) {
            if (MODE == 0) {
                LAS const float* bp = biasL + (qpos - 64 * t - 4 * hi + 4);
#pragma unroll
                for (int r = 0; r < 16; ++r) { const int kvl = (r & 3) + 8 * (r >> 2); p0[r] = bp[59 - kvl]; p1[r] = bp[27 - kvl]; }
                if (__any(mu != 0.f)) {
#pragma unroll
                    for (int r = 0; r < 16; ++r) { p0[r] -= mu; p1[r] -= mu; } }
            } else {
                LAS const float* kb = (LAS const float*)(lds + L_KB + cur * 256) + 4 * hi; const float noff = -(beta + mu);
#pragma unroll
                for (int g = 0; g < 4; ++g) { const f32x4 a = *(LAS const f32x4*)(kb + 8 * g), c = *(LAS const f32x4*)(kb + 32 + 8 * g);
#pragma unroll
                    for (int e = 0; e < 4; ++e) { p0[4 * g + e] = ffma_s(a[e], -LOG2E, noff); p1[4 * g + e] = ffma_s(c[e], -LOG2E, noff); } }
            }
#pragma unroll
            for (int s = 0; s < 4; ++s) {
                p0 = __builtin_amdgcn_mfma_f32_32x32x16_bf16(kf[2 * s], qr[s], p0, 0, 0, 0);
                p1 = __builtin_amdgcn_mfma_f32_32x32x16_bf16(kf[2 * s + 1], qr[s], p1, 0, 0, 0);
            }
            LAS const unsigned char* vp = lds + L_V + cur * 8192 + vlane;
#pragma unroll
            for (int s = 0; s < 4; ++s) { vf[4 * s] = vtr(vp + s * 1024); vf[4 * s + 1] = vtr(vp + s * 1024 + 512); vf[4 * s + 2] = vtr(vp + 4096 + s * 1024); vf[4 * s + 3] = vtr(vp + 4096 + s * 1024 + 512); }
        }
        if (i + 1 < nt) {
#pragma unroll
            for (int s = 0; s < 4; ++s) { kf[2 * s] = *(LAS const bf16x8*)(lds + L_K + nxt * 8192 + kfoff + s * 2048); kf[2 * s + 1] = *(LAS const bf16x8*)(lds + L_K + nxt * 8192 + kfoff + s * 2048 + 512); }
        }
        if (act) {
            if (MODE == 1 && t == cq) {
                const int kp0 = 64 * t + 4 * hi;
#pragma unroll
                for (int r = 0; r < 16; ++r) { const int kvp = kp0 + (r & 3) + 8 * (r >> 2); if (kvp > qpos) p0[r] = -1e30f; if (kvp + 32 > qpos) p1[r] = -1e30f; }
            }
            float mt = __builtin_fmaxf(__builtin_fmaxf(p0[0], p1[0]), p0[1]);
#pragma unroll
            for (int r = 1; r < 16; ++r) { if (r > 1) mt = __builtin_fmaxf(__builtin_fmaxf(mt, p0[r]), p1[r]); else mt = __builtin_fmaxf(mt, p1[1]); }
            mt = xhalf_max(mt);
            if (__any(mt > THR)) {
                const float d = fmaxf(mt, 0.f), f = __builtin_amdgcn_exp2f(-d); mu += d; lrun *= f;
#pragma unroll
                for (int r = 0; r < 16; ++r) { p0[r] -= d; p1[r] -= d; o0[r] *= f; o1[r] *= f; }
            }
#pragma unroll
            for (int r = 0; r < 16; ++r) { p0[r] = __builtin_amdgcn_exp2f(p0[r]); p1[r] = __builtin_amdgcn_exp2f(p1[r]); }
            float ls0 = 0.f, ls1 = 0.f;
#pragma unroll
            for (int r = 0; r < 16; r += 4) { ls0 = fadd4_tr(ls0, p0[r], p0[r + 1], p0[r + 2], p0[r + 3]); ls1 = fadd4_tr(ls1, p1[r], p1[r + 1], p1[r + 2], p1[r + 3]); }
            lrun = fadd_s(lrun, fadd_s(ls0, ls1));
#pragma unroll
            for (int s = 0; s < 4; ++s) {
                u32x4 pw;
                unsigned w0_, w1_, w2_, w3_;
                if (s == 0) { cvtpk2_tr(w0_, w1_, p0[0], p0[1], p0[2], p0[3]); cvtpk2_tr(w2_, w3_, p0[4], p0[5], p0[6], p0[7]); }
                else if (s == 1) { cvtpk2_tr(w0_, w1_, p0[8], p0[9], p0[10], p0[11]); cvtpk2_tr(w2_, w3_, p0[12], p0[13], p0[14], p0[15]); }
                else if (s == 2) { cvtpk2_tr(w0_, w1_, p1[0], p1[1], p1[2], p1[3]); cvtpk2_tr(w2_, w3_, p1[4], p1[5], p1[6], p1[7]); }
                else { cvtpk2_tr(w0_, w1_, p1[8], p1[9], p1[10], p1[11]); cvtpk2_tr(w2_, w3_, p1[12], p1[13], p1[14], p1[15]); }
                pw = (u32x4){w0_, w1_, w2_, w3_};
                const bf16x8 pb = __builtin_bit_cast(bf16x8, pw);
                const s16x4 a0 = vf[4 * s], a1 = vf[4 * s + 1], c0 = vf[4 * s + 2], c1 = vf[4 * s + 3];
                const bf16x8 v0 = (bf16x8){a0[0], a0[1], a0[2], a0[3], a1[0], a1[1], a1[2], a1[3]};
                const bf16x8 v1 = (bf16x8){c0[0], c0[1], c0[2], c0[3], c1[0], c1[1], c1[2], c1[3]};
                o0 = __builtin_amdgcn_mfma_f32_32x32x16_bf16(v0, pb, o0, 0, 0, 0);
                o1 = __builtin_amdgcn_mfma_f32_32x32x16_bf16(v1, pb, o1, 0, 0, 0);
            }
        }
        { const int rem = nt - i - 3; ATT_WAITB(rem > 2 ? 2 : (rem < 0 ? 0 : rem)); }
        cur = nxt;
    }
#undef ATT_DMA
#undef ATT_WAITB
    const float ltot = fmaxf(xhalf_sum(lrun), 1e-37f); const float inv = __builtin_amdgcn_rcpf(ltot);
    unsigned ox[8], oy[8];
#pragma unroll
    for (int g = 0; g < 4; ++g) {
        ox[g] = cvtpk_c(o0[4 * g] * inv, o0[4 * g + 1] * inv); oy[g] = cvtpk_c(o0[4 * g + 2] * inv, o0[4 * g + 3] * inv);
        ox[4 + g] = cvtpk_c(o1[4 * g] * inv, o1[4 * g + 1] * inv); oy[4 + g] = cvtpk_c(o1[4 * g + 2] * inv, o1[4 * g + 3] * inv);
    }
    bf16_t* Ow = O + (rowbase + q0 + wid * 32 + r32) * DM + h * HD + 8 * hi;
#pragma unroll
    for (int k = 0; k < 8; k += 2) {
        const auto rx = __builtin_amdgcn_permlane32_swap(ox[k], ox[k + 1], false, false);
        const auto ry = __builtin_amdgcn_permlane32_swap(oy[k], oy[k + 1], false, false);
        *(u32x4*)(Ow + 8 * k) = (u32x4){rx[0], ry[0], rx[1], ry[1]};
    }
}
}

__device__ __forceinline__ float wave_sum(float v) {
#pragma unroll
    for (int o = 1; o < 64; o <<= 1) v += __shfl_xor(v, o);
    return v;
}
__device__ __forceinline__ void cvt_item(const float* W, int K, int N, const float* gain, bf16_t* WT, int drow0, int k0, int n0, LAS float* scr, int lane, bool f16) {
    const int n = n0 + (lane & 31); const bool ok = n < N;
    float v[32];
    { const float* src = W + (size_t)(k0 + (lane >> 5)) * N + n;
#pragma unroll
      for (int i = 0; i < 32; ++i) v[i] = ok ? src[(size_t)(2 * i) * N] : 0.f; }
#pragma unroll
    for (int i = 0; i < 32; ++i) scr[(2 * i + (lane >> 5)) * 33 + (lane & 31)] = v[i];
    f32x4 g0 = (f32x4){1.f, 1.f, 1.f, 1.f}, g1 = g0;
    if (gain) { g0 = *(const f32x4*)(gain + k0 + 8 * (lane & 7)); g1 = *(const f32x4*)(gain + k0 + 8 * (lane & 7) + 4); }
    asm volatile("s_waitcnt lgkmcnt(0)" ::: "memory");
    const int c = lane & 7;
#pragma unroll
    for (int j = 0; j < 4; ++j) { const int nn = (lane >> 3) + 8 * j; const LAS float* s = scr + (8 * c) * 33 + nn;
        u32x4 o;
        const float e0 = s[0 * 33] * g0.x, e1 = s[1 * 33] * g0.y, e2 = s[2 * 33] * g0.z, e3 = s[3 * 33] * g0.w, e4 = s[4 * 33] * g1.x, e5 = s[5 * 33] * g1.y, e6 = s[6 * 33] * g1.z, e7 = s[7 * 33] * g1.w;
        if (f16) { o.x = pack_h2(e0, e1); o.y = pack_h2(e2, e3); o.z = pack_h2(e4, e5); o.w = pack_h2(e6, e7); }
        else { o.x = pg8::cvt_pk_bf16(e0, e1); o.y = pg8::cvt_pk_bf16(e2, e3); o.z = pg8::cvt_pk_bf16(e4, e5); o.w = pg8::cvt_pk_bf16(e6, e7); }
        *(u32x4*)(WT + (size_t)(drow0 + nn) * K + k0 + 8 * c) = o; }
    asm volatile("s_waitcnt lgkmcnt(0)" ::: "memory");
}

#define XB_TMO      128
#define XB_XCNT(j)  (256  + 64 * (j))
#define XB_XSUB(j)  (1280 + 64 * (j))
#define XB_XGEN(j)  (2304 + 64 * (j))
#define XB_TOP      3328
#define XB_TOPGEN   3392
#define XCD_BAR_WORDS 3456
#define XB_SPIN_CAP (1u << 22)
__device__ __forceinline__ unsigned xb_ld(unsigned* p)              { return __hip_atomic_load(p, __ATOMIC_RELAXED, __HIP_MEMORY_SCOPE_AGENT); }
__device__ __forceinline__ unsigned xb_add(unsigned* p, unsigned v) { return __hip_atomic_fetch_add(p, v, __ATOMIC_RELAXED, __HIP_MEMORY_SCOPE_AGENT); }
__device__ __forceinline__ unsigned xb_xcc_id() { return (unsigned)__builtin_amdgcn_s_getreg((3 << 11) | 20) & 0xFu; }
#define XB_SPIN(cond, bar) do { unsigned _sp = 0; while (cond) { __builtin_amdgcn_s_sleep(1); \
    if ((++_sp & 255u) == 0u) { if (xb_ld(&(bar)[XB_TMO])) break; if (_sp > XB_SPIN_CAP) { atomicAdd(&(bar)[XB_TMO], 1u); break; } } } } while (0)
struct XcdBarrier { unsigned* bar; unsigned x; volatile LAS unsigned* st; };
__device__ __forceinline__ XcdBarrier xcd_barrier_post(unsigned* bar, volatile LAS unsigned* st) {
    XcdBarrier b; b.bar = bar; b.x = xb_xcc_id(); b.st = st;
    if (threadIdx.x == 0) (void)xb_add(&bar[XB_XCNT(b.x)], 1u);
    return b;
}
__device__ __forceinline__ void xcd_barrier_complete(unsigned* bar, unsigned x, unsigned& nloc, unsigned& nx) {
    const unsigned G = gridDim.x * gridDim.y * gridDim.z;
    unsigned sum, cnt, mine, sp = 0u;
    for (;;) {
        sum = 0u; cnt = 0u; mine = 0u;
#pragma unroll
        for (unsigned j = 0; j < 16; ++j) { const unsigned c = xb_ld(&bar[XB_XCNT(j)]); sum += c; cnt += (c > 0u) ? 1u : 0u; mine = (j == x) ? c : mine; }
        if (sum == G) break;
        __builtin_amdgcn_s_sleep(1);
        if ((++sp & 255u) == 0u) { if (xb_ld(&bar[XB_TMO])) break; if (sp > XB_SPIN_CAP) { atomicAdd(&bar[XB_TMO], 1u); break; } }
    }
    nloc = mine > 0u ? mine : 1u; nx = cnt > 0u ? cnt : 1u;
}
__device__ __forceinline__ void xcd_barrier(const XcdBarrier& b) {
    asm volatile("s_waitcnt vmcnt(0)" ::: "memory");
    __syncthreads();
    if (threadIdx.x == 0) {
        unsigned* bar = b.bar;
        __builtin_amdgcn_s_waitcnt(0);
        unsigned nloc = b.st[0], nx = b.st[1];
        if (nloc == 0u) { xcd_barrier_complete(bar, b.x, nloc, nx); b.st[0] = nloc; b.st[1] = nx; }
        const unsigned old = xb_add(&bar[XB_XSUB(b.x)], 1u);
        const unsigned gen = old / nloc;
        if (old + 1u == (gen + 1u) * nloc) {
            __builtin_amdgcn_fence(__ATOMIC_RELEASE, "agent");
            asm volatile("s_waitcnt vmcnt(0)" ::: "memory");
            const unsigned og = xb_add(&bar[XB_TOP], 1u);
            const unsigned tg = og / nx;
            if (og + 1u == (tg + 1u) * nx) xb_add(&bar[XB_TOPGEN], 1u);
            else XB_SPIN(xb_ld(&bar[XB_TOPGEN]) == tg, bar);
            __builtin_amdgcn_fence(__ATOMIC_ACQUIRE, "agent");
            xb_add(&bar[XB_XGEN(b.x)], 1u);
            asm volatile("s_waitcnt vmcnt(0)" ::: "memory");
        } else {
            XB_SPIN(xb_ld(&bar[XB_XGEN(b.x)]) == gen, bar);
            __builtin_amdgcn_fence(__ATOMIC_ACQUIRE, "agent");
            asm volatile("s_waitcnt vmcnt(0)" ::: "memory");
        }
    }
    __syncthreads();
}

#define GB_CNT(g)   (3456 + 64 * (g))
#define GB_MASK(g)  (4096 + 64 * (g))
#define BAR_ZERO_WORDS 4608
__device__ __forceinline__ void group_barrier(unsigned* bar, unsigned g, unsigned nmem) {
    asm volatile("s_waitcnt vmcnt(0)" ::: "memory");
    __syncthreads();
    if (threadIdx.x == 0) {
        __builtin_amdgcn_s_waitcnt(0);
        const unsigned old = xb_add(&bar[GB_CNT(g)], 1u);
        const unsigned target = (old / nmem + 1u) * nmem;
        XB_SPIN(xb_ld(&bar[GB_CNT(g)]) < target, bar);
        __builtin_amdgcn_fence(__ATOMIC_ACQUIRE, "agent");
        asm volatile("s_waitcnt vmcnt(0)" ::: "memory");
    }
    __syncthreads();
}

struct Args { const float* in[15]; float* out; unsigned char* ws; };

#ifndef PROBE_A2
#define PROBE_A2 0
#endif
#ifndef PROBE_B2
#define PROBE_B2 0
#endif
#ifndef PROBE_P2
#define PROBE_P2 0
#endif
#ifndef PROBE_GU2
#define PROBE_GU2 0
#endif
#ifndef PROBE_RS2
#define PROBE_RS2 0
#endif
#ifndef PROBE_PJ2
#define PROBE_PJ2 0
#endif
#ifndef PROBE_S2
#define PROBE_S2 0
#endif
constexpr int NTHREADS = 512;
constexpr int LDS_BYTES = 151552;
constexpr int RSTD_OFF = 131072 + 1024;
constexpr int MISC_OFF = 131072 + 320;

__global__ void __launch_bounds__(NTHREADS, 2) yoco_fwd(Args args) {
    extern __shared__ __attribute__((aligned(16))) unsigned char lds_raw[];
    LAS unsigned char* lds = (LAS unsigned char*)lds_raw;
    cg::grid_group grid = cg::this_grid();
    const int tid = threadIdx.x, lane = tid & 63, wave = __builtin_amdgcn_readfirstlane(tid >> 6);
    constexpr int G = 256; const int bx = blockIdx.x;
    unsigned char* ws = args.ws;
    const float* x = args.in[0]; const float* ffn_norm = args.in[1]; const float* w_gate = args.in[2]; const float* w_up = args.in[3]; const float* w_down = args.in[4];
    const float* mix_norm = args.in[5]; const float* a_w_qkv = args.in[6]; const float* a_w_o = args.in[7]; const float* a_rel_bias = args.in[8];
    const float* kv_norm = args.in[9]; const float* b_w_kvf = args.in[10]; const float* b_f_bias = args.in[11]; const float* b_w_q = args.in[12]; const float* b_w_o = args.in[13];
    const float* final_norm = args.in[14];
    float* hout = args.out;

    unsigned* barw = (unsigned*)(ws + WS_BAR);
    volatile LAS unsigned* MISC = (volatile LAS unsigned*)(lds + MISC_OFF);
    if (tid < 2) MISC[tid] = 0u;
    if (bx == 0) for (int i = tid; i < BAR_ZERO_WORDS; i += NTHREADS) __hip_atomic_store(barw + i, 0u, __ATOMIC_RELAXED, __HIP_MEMORY_SCOPE_AGENT);
    {
        LAS float* scr = (LAS float*)(lds + wave * 16384);
        float* ssq = (float*)(ws + WS_SSQ); bf16_t* hb = (bf16_t*)(ws + WS_HB);
        const int gw = bx * 8 + wave, NGW = G * 8;
        constexpr int I_G = (DM / 64) * (FF / 32), I_D = (FF / 64) * (DM / 32), I_FFN = 2 * I_G + I_D;
        constexpr int I_QKV = (DM / 64) * (3 * DM / 32), I_SQ = (DM / 64) * (DM / 32), I_KVF = (DM / 64) * 65;
        constexpr int NITEMS = 8 * I_FFN + 2 * I_QKV + 2 * I_SQ + I_KVF + 2 * I_SQ + 2 * I_SQ;
        for (int rep = 0; rep < 1 + PROBE_P2; ++rep)
        for (int it = gw; it < NITEMS; it += NGW) {
            int r = it;
            if (r < 8 * I_FFN) {
                const int idx = r / I_FFN; r -= idx * I_FFN; bf16_t* wgu = (bf16_t*)(ws + WS_W + idx * W_FFN_BLK); bf16_t* wd = (bf16_t*)(ws + WS_W + idx * W_FFN_BLK + W_GU_BYTES);
                if (r < 2 * I_G) { const int s = r / I_G; r -= s * I_G; const int nblk = FF / 32, kb = r / nblk, nb = r % nblk, n0 = nb * 32;
                    cvt_item((s ? w_up : w_gate) + (size_t)idx * DM * FF, DM, FF, ffn_norm + idx * DM, wgu, 256 * (n0 >> 7) + 128 * s + (n0 & 127), kb * 64, n0, scr, lane, true); }
                else { r -= 2 * I_G; const int nblk = DM / 32, kb = r / nblk, nb = r % nblk; cvt_item(w_down + (size_t)idx * FF * DM, FF, DM, nullptr, wd, nb * 32, kb * 64, nb * 32, scr, lane, false); }
                continue;
            }
            r -= 8 * I_FFN;
            if (r < 2 * I_QKV) { const int la = r / I_QKV; r -= la * I_QKV; const int nblk = 3 * DM / 32, kb = r / nblk, nb = r % nblk;
                cvt_item(a_w_qkv + (size_t)la * DM * 3 * DM, DM, 3 * DM, mix_norm + la * DM, (bf16_t*)(ws + WS_WQKV) + (size_t)la * 3 * DM * DM, nb * 32, kb * 64, nb * 32, scr, lane, true); continue; }
            r -= 2 * I_QKV;
            if (r < 2 * I_SQ) { const int la = r / I_SQ; r -= la * I_SQ; const int nblk = DM / 32, kb = r / nblk, nb = r % nblk;
                cvt_item(a_w_o + (size_t)la * DM * DM, DM, DM, nullptr, (bf16_t*)(ws + WS_WAO) + (size_t)la * DM * DM, nb * 32, kb * 64, nb * 32, scr, lane, false); continue; }
            r -= 2 * I_SQ;
            if (r < I_KVF) { const int nblk = 65, kb = r / nblk, nb = r % nblk;
                cvt_item(b_w_kvf, DM, 2 * DM + NH, kv_norm, (bf16_t*)(ws + WS_WKVF), nb * 32, kb * 64, nb * 32, scr, lane, true); continue; }
            r -= I_KVF;
            if (r < 2 * I_SQ) { const int lb = r / I_SQ; r -= lb * I_SQ; const int nblk = DM / 32, kb = r / nblk, nb = r % nblk;
                cvt_item(b_w_q + (size_t)lb * DM * DM, DM, DM, mix_norm + (2 + lb) * DM, (bf16_t*)(ws + WS_WBQ) + (size_t)lb * DM * DM, nb * 32, kb * 64, nb * 32, scr, lane, true); continue; }
            r -= 2 * I_SQ;
            { const int lb = r / I_SQ; r -= lb * I_SQ; const int nblk = DM / 32, kb = r / nblk, nb = r % nblk;
                cvt_item(b_w_o + (size_t)lb * DM * DM, DM, DM, nullptr, (bf16_t*)(ws + WS_WBO) + (size_t)lb * DM * DM, nb * 32, kb * 64, nb * 32, scr, lane, false); }
        }
        for (int m = gw; m < TOK; m += NGW) {
            const f32x4* xr = (const f32x4*)(x + (size_t)m * DM) + lane; f32x4 v[4]; float s = 0.f;
#pragma unroll
            for (int j = 0; j < 4; ++j) v[j] = xr[64 * j];
            u32x2* o8 = (u32x2*)(hb + (size_t)m * DM) + lane;
#pragma unroll
            for (int j = 0; j < 4; ++j) { const u32x2 w = (u32x2){pack_h2(v[j].x, v[j].y), pack_h2(v[j].z, v[j].w)}; o8[64 * j] = w;
                const float r0 = h_lo(w.x), r1 = h_hi(w.x), r2 = h_lo(w.y), r3 = h_hi(w.y); s += (r0 * r0 + r1 * r1) + (r2 * r2 + r3 * r3); }
            s = wave_sum(s);
            if (lane < 16) ssq[(size_t)m * 16 + lane] = lane == 0 ? s : 0.f;
        }
    }
    __syncthreads();
    grid.sync();
    const XcdBarrier xb = xcd_barrier_post(barw, MISC);
    const int grp = bx & 7, gj = bx >> 3; constexpr int GJ = G >> 3;
    if (tid == 0) __hip_atomic_fetch_or(barw + GB_MASK(grp), 1u << xb.x, __ATOMIC_RELAXED, __HIP_MEMORY_SCOPE_AGENT);
    bool use_group = false;

#pragma unroll 1
    for (int opi = 0; opi < 58; ++opi) {
        const int op = opi >> 1, rep = opi & 1;
        unsigned char* wsv = args.ws; asm volatile("" : "+s"(wsv));
        float* ssq = (float*)(wsv + WS_SSQ); float* flog = (float*)(wsv + WS_FLOG); float* cum = (float*)(wsv + WS_CUM);
        bf16_t* hb = (bf16_t*)(wsv + WS_HB);
        bf16_t* Rq = (bf16_t*)(wsv + WS_R + (size_t)(bx & 7) * (16 * MiB)); bf16_t* Rk = Rq + (size_t)SEQ * DM; bf16_t* Rv = Rk + (size_t)SEQ * DM;
        bf16_t* mid = (bf16_t*)(wsv + WS_R + (size_t)(bx & 7) * (2 * MiB));
        bf16_t* Ksh = (bf16_t*)(wsv + WS_KSH); bf16_t* Vsh = (bf16_t*)(wsv + WS_VSH);
        unsigned char* ws = wsv;
        int tidv = threadIdx.x; asm volatile("" : "+v"(tidv));
        int l, j;
        if (op < 14) { l = op / 7; j = op % 7; } else if (op == 14) { l = 2; j = 7; } else { l = 2 + (op - 15) / 7; j = (op - 15) % 7; }
        const bool dbl = (PROBE_GU2 && (j == 0 || j == 5)) || (PROBE_RS2 && (j == 1 || j == 6 || j == 4)) || (PROBE_PJ2 && (j == 2 || j == 7));
        if (rep == 0 && !dbl) continue;
        const int p = j >= 5 ? 1 : 0;
        const int idx = l * 2 + p;
        const LAS float* rstdL = (const LAS float*)(lds + RSTD_OFF);
        if (j == 0 || j == 5 || j == 2 || j == 7) {
            const GAS float* sp = (const GAS float*)ssq + ((size_t)grp * SEQ + tidv * 8) * 16;
#pragma unroll
            for (int r = 0; r < 8; ++r) { const f32x4 a = *(const GAS f32x4*)(sp + r * 16), b2 = *(const GAS f32x4*)(sp + r * 16 + 4), c = *(const GAS f32x4*)(sp + r * 16 + 8), d = *(const GAS f32x4*)(sp + r * 16 + 12);
                const float ssum = ((a.x + a.y) + (a.z + a.w)) + ((b2.x + b2.y) + (b2.z + b2.w)) + ((c.x + c.y) + (c.z + c.w)) + ((d.x + d.y) + (d.z + d.w));
                ((LAS float*)(lds + RSTD_OFF))[tidv * 8 + r] = __builtin_amdgcn_rsqf(ssum * (1.0f / DM) + EPS); }
            __syncthreads();
        }
        if (j == 7) {
            const int ln = tidv & 63, wv = __builtin_amdgcn_readfirstlane(tidv >> 6), m16 = ln & 15, kg = ln >> 4;
            const int rowl = gj * 128 + wv * 16 + m16;
            const GAS bf16_t* ap = (const GAS bf16_t*)hb + ((size_t)grp * SEQ + rowl) * DM + 8 * kg;
            const GAS bf16_t* wp = (const GAS bf16_t*)(ws + WS_WKVF) + (size_t)(2 * DM + m16) * DM + 8 * kg;
            f32x4 fa = {0.f, 0.f, 0.f, 0.f};
#pragma unroll 8
            for (int st = 0; st < 32; ++st) {
                const bf16x8 av = *(const GAS bf16x8*)(ap + 32 * st), wv8 = *(const GAS bf16x8*)(wp + 32 * st);
                fa = __builtin_amdgcn_mfma_f32_16x16x32_f16(__builtin_bit_cast(f16x8, wv8), __builtin_bit_cast(f16x8, av), fa, 0, 0, 0);
            }
            const float rr = rstdL[rowl];
            const f32x4 bb = *(const GAS f32x4*)((const GAS float*)b_f_bias + 4 * kg); f32x4 fo;
#pragma unroll
            for (int e = 0; e < 4; ++e) { const float xx = fa[e] * rr + bb[e]; fo[e] = fminf(xx, 0.f) - 0.6931471805599453f * __builtin_amdgcn_logf(1.0f + __builtin_amdgcn_exp2f(-fabsf(xx) * LOG2E)); }
            *(GAS f32x4*)((GAS float*)flog + ((size_t)grp * SEQ + rowl) * 16 + 4 * kg) = fo;
        }
        if (j == 0 || j == 5) {
            pg8::Gemm g{hb, (const bf16_t*)(ws + WS_W + idx * W_FFN_BLK), TOK, 2 * FF, DM}; pg8::StaticOrder S; S.init(TOK, 2 * FF, G, bx);
            pg8::EpiSwiglu E{mid, rstdL, grp * SEQ};
            pg8::gemm_phase<pg8::EpiSwiglu, pg8::StaticOrder, true, true>(lds, g, S, E, tidv);
        } else if (j == 1 || j == 6 || j == 4) {
            if (op == 16 && gj < NH) {
                const int b = grp, hh = gj; const float* src = flog + ((size_t)b * SEQ + tid * 8) * 16 + hh; float v[8];
#pragma unroll
                for (int i = 0; i < 8; ++i) v[i] = src[(size_t)i * 16];
#pragma unroll
                for (int i = 1; i < 8; ++i) v[i] += v[i - 1];
                float incl = v[7];
#pragma unroll
                for (int o = 1; o < 64; o <<= 1) { const float t2 = __shfl_up(incl, o); if (lane >= o) incl += t2; }
                volatile LAS float* wtot = (volatile LAS float*)(lds + MISC_OFF + 64);
                if (lane == 63) wtot[wave] = incl;
                __syncthreads();
                float base = incl - v[7];
                for (int w = 0; w < wave; ++w) base += wtot[w];
                float* dst = cum + ((size_t)b * NH + hh) * SEQ + tid * 8;
                *(f32x4*)dst = (f32x4){base + v[0], base + v[1], base + v[2], base + v[3]}; *(f32x4*)(dst + 4) = (f32x4){base + v[4], base + v[5], base + v[6], base + v[7]};
            }
            const bool isO = (j == 4);
            const bf16_t* A = isO ? Rq : mid;
            const bf16_t* Bt = isO ? (l < 2 ? (const bf16_t*)(ws + WS_WAO) + (size_t)l * DM * DM : (const bf16_t*)(ws + WS_WBO) + (size_t)(l - 2) * DM * DM)
                                   : (const bf16_t*)(ws + WS_W + idx * W_FFN_BLK + W_GU_BYTES);
            pg8::Gemm g{A, Bt, TOK, DM, isO ? DM : FF}; pg8::StaticOrder S; S.init(TOK, DM, G, bx);
            pg8::EpiResid E{hb, ssq, (dbl && rep == 0) ? 0.0f : (isO ? 1.0f : 0.5f)};
            pg8::gemm_phase<pg8::EpiResid, pg8::StaticOrder, true, true>(lds, g, S, E, tidv);
        } else if (j == 2 || j == 7) {
            const bf16_t* Bt; int N; bf16_t* O0; long ostr; float sc; float* fl = nullptr;
            if (j == 7) { Bt = (const bf16_t*)(ws + WS_WKVF); N = 2 * DM; O0 = Ksh; ostr = (long)((WS_VSH - WS_KSH) / 2); sc = 1.0f; }
            else if (l < 2) { Bt = (const bf16_t*)(ws + WS_WQKV) + (size_t)l * 3 * DM * DM; N = 3 * DM; O0 = Rq; ostr = (long)SEQ * DM; sc = QSCALE; }
            else { Bt = (const bf16_t*)(ws + WS_WBQ) + (size_t)(l - 2) * DM * DM; N = DM; O0 = Rq; ostr = 0; sc = QSCALE; }
            pg8::Gemm g{hb, Bt, TOK, N, DM}; pg8::StaticOrder S; S.init(TOK, N, G, bx);
            pg8::EpiProj E{O0, ostr, rstdL, grp * SEQ, sc, fl, b_f_bias};
            pg8::gemm_phase<pg8::EpiProj, pg8::StaticOrder, true, true>(lds, g, S, E, tidv);
        } else {
            if (l < 2) {
                for (int v = gj; v < NH * 16; v += GJ) { const int hh = v & 15, qb = v >> 4;
                    if (PROBE_A2) att::attn_unit<0>(lds, Rq, Rk, Rv, Vsh, a_rel_bias + (size_t)l * NH * NREL, grp, hh, qb, tidv);
                    att::attn_unit<0>(lds, Rq, Rk, Rv, Rq, a_rel_bias + (size_t)l * NH * NREL, grp, hh, qb, tidv); }
            } else {
                for (int i = 0; i < 8; ++i) { const int hh = 4 * (gj >> 3) + (i >> 1), sidx = gj & 7, qb = (i & 1) ? 15 - sidx : sidx;
                    if (PROBE_B2) att::attn_unit<1>(lds, Rq, Ksh, Vsh, Rk, cum, grp, hh, qb, tidv);
                    att::attn_unit<1>(lds, Rq, Ksh, Vsh, Rq, cum, grp, hh, qb, tidv); }
            }
        }
        if (op != 14) {
            if (use_group && op != 13) group_barrier(barw, (unsigned)grp, (unsigned)GJ);
            else { xcd_barrier(xb);
                if (op == 0) {
                    bool ok = true;
#pragma unroll
                    for (int g = 0; g < 8; ++g) { const unsigned mk = xb_ld(barw + GB_MASK(g)); ok = ok && (mk != 0u) && ((mk & (mk - 1u)) == 0u); }
                    use_group = ok && !PROBE_S2; } }
        }
    }

    {
        const bf16_t* hb = (const bf16_t*)(ws + WS_HB);
        for (int r = gj * 8 + wave; r < SEQ; r += GJ * 8) { const int m = grp * SEQ + r;
            const u32x2* hr = (const u32x2*)(hb + (size_t)m * DM) + lane; f32x4* xr = (f32x4*)(hout + (size_t)m * DM) + lane; const f32x4* gr = (const f32x4*)final_norm + lane; f32x4 v[4]; float s = 0.f;
#pragma unroll
            for (int jj = 0; jj < 4; ++jj) { const u32x2 w = hr[64 * jj]; v[jj] = (f32x4){h_lo(w.x), h_hi(w.x), h_lo(w.y), h_hi(w.y)}; s += (v[jj].x * v[jj].x + v[jj].y * v[jj].y) + (v[jj].z * v[jj].z + v[jj].w * v[jj].w); }
            const float rs = rsqrtf(wave_sum(s) * (1.0f / DM) + EPS);
#pragma unroll
            for (int jj = 0; jj < 4; ++jj) xr[64 * jj] = v[jj] * rs * gr[64 * jj];
        }
    }
}

extern "C" void kernel_launch(void* const* d_in, const int* in_sizes, int n_in, void* d_out, int out_size, void* d_ws, size_t ws_size, hipStream_t stream) {
    static int grid = 0;
    if (grid == 0) {
        if (n_in != 15 || out_size != TOK * DM || ws_size < WS_END) { fprintf(stderr, "kernel_launch: unexpected shapes (n_in %d out %d ws %zu)\n", n_in, out_size, ws_size); grid = -1; return; }
        int dev = 0, cus = 0, per_cu = 0;
        hipGetDevice(&dev); hipDeviceGetAttribute(&cus, hipDeviceAttributeMultiprocessorCount, dev);
        if (hipFuncSetAttribute((const void*)yoco_fwd, hipFuncAttributeMaxDynamicSharedMemorySize, LDS_BYTES) != hipSuccess) { fprintf(stderr, "kernel_launch: hipFuncSetAttribute failed\n"); grid = -1; return; }
        if (hipOccupancyMaxActiveBlocksPerMultiprocessor(&per_cu, (const void*)yoco_fwd, NTHREADS, LDS_BYTES) != hipSuccess || per_cu < 1) { fprintf(stderr, "kernel_launch: occupancy query says %d\n", per_cu); per_cu = 1; }
        (void)hipGetLastError();
        if (cus < 256) fprintf(stderr, "kernel_launch: this kernel needs 256 CUs (device reports %d)\n", cus);
        grid = 256;
    }
    if (grid < 0) return;
    Args a{};
    for (int i = 0; i < 15; ++i) a.in[i] = (const float*)d_in[i];
    a.out = (float*)d_out; a.ws = (unsigned char*)d_ws;
    void* kargs[] = {&a};
    hipError_t e = hipLaunchCooperativeKernel((const void*)yoco_fwd, dim3(grid), dim3(NTHREADS), kargs, LDS_BYTES, stream);
    if (e != hipSuccess) fprintf(stderr, "cooperative launch failed: %s (grid %d)\n", hipGetErrorString(e), grid);
}
```

```cpp
#include <hip/hip_runtime.h>
#include <hip/hip_cooperative_groups.h>
#include <cstdio>
#include <cstdint>
namespace cg = cooperative_groups;

#define LAS __attribute__((address_space(3)))
typedef unsigned short bf16_t;
typedef short bf16x8 __attribute__((ext_vector_type(8)));
typedef short s16x4 __attribute__((ext_vector_type(4)));
typedef float f32x4 __attribute__((ext_vector_type(4)));
typedef float f32x16 __attribute__((ext_vector_type(16)));
typedef unsigned u32x4 __attribute__((ext_vector_type(4)));
typedef unsigned u32x2 __attribute__((ext_vector_type(2)));
typedef _Float16 f16x8 __attribute__((ext_vector_type(8)));
typedef _Float16 f16x2 __attribute__((ext_vector_type(2)));
__device__ __forceinline__ unsigned pack_h2(float a, float b) { const f16x2 v = {(_Float16)a, (_Float16)b}; return __builtin_bit_cast(unsigned, v); }
__device__ __forceinline__ float h_lo(unsigned w) { return (float)__builtin_bit_cast(f16x2, w).x; }
__device__ __forceinline__ float h_hi(unsigned w) { return (float)__builtin_bit_cast(f16x2, w).y; }

constexpr int BATCH = 8, SEQ = 4096, DM = 1024, NH = 16, HD = 64, FF = 2816, TOK = BATCH * SEQ, NREL = 513;
constexpr float EPS = 1e-6f;
constexpr float LOG2E = 1.4426950408889634f;
constexpr float QSCALE = 0.125f * LOG2E;

constexpr size_t MiB = 1u << 20;
constexpr size_t WS_SSQ = 0;
constexpr size_t WS_FLOG = 2 * MiB;
constexpr size_t WS_CUM = 4 * MiB;
constexpr size_t WS_BAR = 6 * MiB;
constexpr size_t WS_W = 8 * MiB;
constexpr size_t W_FFN_BLK = (size_t)(2 * FF * DM + DM * FF) * 2;
constexpr size_t W_GU_BYTES = (size_t)2 * FF * DM * 2;
constexpr size_t WS_WQKV = WS_W + 8 * W_FFN_BLK;
constexpr size_t WS_WAO = WS_WQKV + 2 * (size_t)3 * DM * DM * 2;
constexpr size_t WS_WKVF = WS_WAO + 2 * (size_t)DM * DM * 2;
constexpr size_t WS_WBQ = WS_WKVF + (size_t)2304 * DM * 2;
constexpr size_t WS_WBO = WS_WBQ + 2 * (size_t)DM * DM * 2;
constexpr size_t WS_WEND = WS_WBO + 2 * (size_t)DM * DM * 2;
constexpr size_t WS_HB = 169 * MiB;
constexpr size_t WS_R = 233 * MiB;
constexpr size_t WS_VSH = 425 * MiB;
constexpr size_t WS_KSH = WS_W;
constexpr size_t WS_END = 489 * MiB;
static_assert(WS_WEND <= WS_HB, "weights overflow");
static_assert(4 * W_FFN_BLK >= (size_t)TOK * DM * 2, "K_sh overlay must fit in the layer 0/1 FFN weights");
static_assert((size_t)SEQ * FF * 2 <= 24 * MiB && 3 * (size_t)SEQ * DM * 2 <= 24 * MiB && 8 * 24 * MiB <= WS_VSH - WS_R, "per-batch regions fit R");

namespace pg8 {
constexpr int BM = 256, BK = 64, HALF = 128, HTB = HALF * BK * 2, STAGE_BYTES = 8 * HTB, NXCD = 8, WGM = 4;
__host__ __device__ __forceinline__ int lds_byte(int r, int c) { const int st = (r >> 4) * 2 + (c >> 5), rr = r & 15, cc = c & 31, ob = rr * 64 + cc * 2; return st * 1024 + (ob ^ (((ob >> 9) & 1) << 5)); }
__host__ __device__ __forceinline__ void stage_rc(int b, int& R, int& C) { const int st = b / 1024, sb = b % 1024, swz = sb ^ (((sb >> 9) & 1) << 5); R = (st >> 1) * 16 + swz / 64; C = (st & 1) * 32 + (swz % 64) / 2; }
__host__ __device__ __forceinline__ int perm32(int rho) { const int n = rho >> 4, i = rho & 15; return 8 * (i >> 2) + 4 * n + (i & 3); }

struct Unit { int pm, pn; };
struct Gemm { const bf16_t* A; const bf16_t* Bt; int M, N, K; };

struct StaticOrder {
    int nM, nN, nwg, G, c;
    __host__ __device__ void init(int M, int N, int G_, int c_) { nM = M / BM; nN = N / BM; nwg = nM * nN; G = G_; c = c_; }
    __host__ __device__ bool next(int i, Unit& u) const {
        const long L = (long)i * G + c; if (L >= nwg) return false;
        int wgid = (int)L; { const int q = nwg / NXCD, r = nwg % NXCD, xcd = wgid % NXCD, off = wgid / NXCD; wgid = (xcd < r ? xcd * (q + 1) : r * (q + 1) + (xcd - r) * q) + off; }
        const int nig = WGM * nN, gid = wgid / nig, fm = gid * WGM, gsz = (nM - fm) < WGM ? (nM - fm) : WGM;
        u.pm = fm + ((wgid % nig) % gsz); u.pn = (wgid % nig) / gsz; return true;
    }
    __device__ __forceinline__ void a_ready(const Unit&) const {}
    __device__ __forceinline__ void done(const Unit&) const {}
};

__device__ __forceinline__ unsigned cvt_pk_bf16(float lo, float hi) { unsigned r; asm volatile("v_cvt_pk_bf16_f32 %0, %1, %2" : "=v"(r) : "v"(lo), "v"(hi)); return r; }

__device__ __forceinline__ float fq_sum(float v) {
    auto a = __builtin_amdgcn_permlane16_swap(__float_as_uint(v), __float_as_uint(v), false, false); v = __uint_as_float(a[0]) + __uint_as_float(a[1]);
    auto b = __builtin_amdgcn_permlane32_swap(__float_as_uint(v), __float_as_uint(v), false, false); return __uint_as_float(b[0]) + __uint_as_float(b[1]);
}
#define GAS __attribute__((address_space(1)))
__device__ __forceinline__ float fmul_s(float a, float b) { float r; asm("v_mul_f32_e32 %0, %1, %2" : "=v"(r) : "v"(a), "v"(b)); return r; }
__device__ __forceinline__ float row_rstd(const GAS float* ssq, int row, int fq) {
    const f32x4 pp = *(const GAS f32x4*)(ssq + (size_t)row * 16 + 4 * fq);
    const float s = fq_sum((pp.x + pp.y) + (pp.z + pp.w));
    return __builtin_amdgcn_rsqf(s * (1.0f / DM) + EPS);
}

struct EpiSwiglu {
    static constexpr bool PERM = true, AFTER_DRAIN = false, F16 = true;
    bf16_t* O; const LAS float* rstd; int rowbase;
    __device__ __forceinline__ void operator()(const f32x4 (&acc)[2][2][4][2], const Unit& u, int wr, int wc, int fr, int fq) const {
        const int row0 = u.pm * BM + wr * 64 + fr, col0 = u.pn * HALF + wc * 32 + 8 * fq;
        GAS bf16_t* O_g = (GAS bf16_t*)O;
        float rs[8];
#pragma unroll
        for (int i = 0; i < 8; ++i) rs[i] = rstd[row0 + (i >> 2) * HALF + (i & 3) * 16 - rowbase];
#pragma unroll
        for (int ai = 0; ai < 2; ++ai)
#pragma unroll
            for (int m = 0; m < 4; ++m) {
                const int row = row0 + ai * HALF + m * 16; const float r = rs[ai * 4 + m], nrl = -r * LOG2E, rs2 = r * r;
                unsigned w[4];
#pragma unroll
                for (int n = 0; n < 2; ++n) {
                    const f32x4 g = acc[ai][0][m][n], up = acc[ai][1][m][n];
                    const f32x4 t = g * nrl; f32x4 ex, sg;
#pragma unroll
                    for (int e = 0; e < 4; ++e) ex[e] = __builtin_amdgcn_exp2f(t[e]);
                    const f32x4 d = ex + 1.0f;
#pragma unroll
                    for (int e = 0; e < 4; ++e) sg[e] = __builtin_amdgcn_rcpf(d[e]);
                    const f32x4 y = (g * up) * (sg * rs2);
                    w[2 * n] = cvt_pk_bf16(y[0], y[1]); w[2 * n + 1] = cvt_pk_bf16(y[2], y[3]);
                }
                *(GAS u32x4*)(O_g + (size_t)row * FF + col0) = (u32x4){w[0], w[1], w[2], w[3]};
            }
    }
};

__device__ __forceinline__ float bf_lo(unsigned w) { return __uint_as_float(w << 16); }
__device__ __forceinline__ float bf_hi(unsigned w) { return __uint_as_float(w & 0xffff0000u); }
struct EpiResid {
    static constexpr bool PERM = true, AFTER_DRAIN = false, F16 = false;
    bf16_t* hb; float* ssq; float alpha;
    __device__ __forceinline__ void operator()(const f32x4 (&acc)[2][2][4][2], const Unit& u, int wr, int wc, int fr, int fq) const {
        const int row0 = u.pm * BM + wr * 64 + fr, col0 = u.pn * BM + wc * 32 + 8 * fq;
        GAS bf16_t* hb_g = (GAS bf16_t*)hb; GAS float* ssq_g = (GAS float*)ssq;
        u32x4 bv[8][2];
#pragma unroll
        for (int q = 0; q < 4; ++q)
#pragma unroll
            for (int bj = 0; bj < 2; ++bj) bv[q][bj] = *(const GAS u32x4*)(hb_g + (size_t)(row0 + (q >> 2) * HALF + (q & 3) * 16) * DM + col0 + bj * HALF);
#pragma unroll
        for (int q = 0; q < 8; ++q) {
            const int ai = q >> 2, m = q & 3;
            const int row = row0 + ai * HALF + m * 16; float ss = 0.f;
#pragma unroll
            for (int bj = 0; bj < 2; ++bj) {
                const size_t off = (size_t)row * DM + col0 + bj * HALF;
                const u32x4 b = bv[q][bj];
                const f32x4 a0 = acc[ai][bj][m][0] * alpha, a1 = acc[ai][bj][m][1] * alpha;
                u32x4 o;
                o.x = pack_h2(h_lo(b.x) + a0[0], h_hi(b.x) + a0[1]); o.y = pack_h2(h_lo(b.y) + a0[2], h_hi(b.y) + a0[3]);
                o.z = pack_h2(h_lo(b.z) + a1[0], h_hi(b.z) + a1[1]); o.w = pack_h2(h_lo(b.w) + a1[2], h_hi(b.w) + a1[3]);
                *(GAS u32x4*)(hb_g + off) = o;
                const float r0 = h_lo(o.x), r1 = h_hi(o.x), r2 = h_lo(o.y), r3 = h_hi(o.y), r4 = h_lo(o.z), r5 = h_hi(o.z), r6 = h_lo(o.w), r7 = h_hi(o.w);
                ss += (r0 * r0 + r1 * r1) + (r2 * r2 + r3 * r3) + (r4 * r4 + r5 * r5) + (r6 * r6 + r7 * r7);
            }
            if (q + 4 < 8) {
#pragma unroll
                for (int bj = 0; bj < 2; ++bj) bv[q + 4][bj] = *(const GAS u32x4*)(hb_g + (size_t)(row0 + ((q + 4) >> 2) * HALF + ((q + 4) & 3) * 16) * DM + col0 + bj * HALF);
            }
            ss = fq_sum(ss);
            if (fq == 0) ssq_g[(size_t)row * 16 + u.pn * 4 + wc] = ss;
        }
    }
};

struct EpiProj {
    static constexpr bool PERM = true, AFTER_DRAIN = false, F16 = true;
    bf16_t* O0; long ostride; const LAS float* rstd; int rowbase; float scale0; float* flog; const float* bf;
    __device__ __forceinline__ void operator()(const f32x4 (&acc)[2][2][4][2], const Unit& u, int wr, int wc, int fr, int fq) const {
        const int row0 = u.pm * BM + wr * 64 + fr; const int t = u.pn >> 2, pnl = u.pn & 3;
        float rs[8];
#pragma unroll
        for (int i = 0; i < 8; ++i) rs[i] = rstd[row0 + (i >> 2) * HALF + (i & 3) * 16 - rowbase];
        if (t == 2 && flog) {
            GAS float* flog_g = (GAS float*)flog; const GAS float* bf_g = (const GAS float*)bf;
            if (wc == 0 && fq < 2) {
                const f32x4 b0 = *(const GAS f32x4*)(bf_g + 8 * fq), b1 = *(const GAS f32x4*)(bf_g + 8 * fq + 4);
#pragma unroll
                for (int ai = 0; ai < 2; ++ai)
#pragma unroll
                    for (int m = 0; m < 4; ++m) {
                        const int row = row0 + ai * HALF + m * 16; const float r = rs[ai * 4 + m]; f32x4 o[2];
#pragma unroll
                        for (int n = 0; n < 2; ++n)
#pragma unroll
                            for (int e = 0; e < 4; ++e) { const float x = acc[ai][0][m][n][e] * r + (n == 0 ? b0[e] : b1[e]);
                                o[n][e] = fminf(x, 0.f) - 0.6931471805599453f * __builtin_amdgcn_logf(1.0f + __builtin_amdgcn_exp2f(-fabsf(x) * LOG2E)); }
                        *(GAS f32x4*)(flog_g + (size_t)row * 16 + 8 * fq) = o[0]; *(GAS f32x4*)(flog_g + (size_t)row * 16 + 8 * fq + 4) = o[1];
                    }
            }
            return;
        }
        GAS bf16_t* O = (GAS bf16_t*)O0 + (long)t * ostride; const float sc = t == 0 ? scale0 : 1.0f;
        const int col0 = pnl * BM + wc * 32 + 8 * fq;
#pragma unroll
        for (int ai = 0; ai < 2; ++ai)
#pragma unroll
            for (int m = 0; m < 4; ++m) {
                const int row = row0 + ai * HALF + m * 16; const float r = rs[ai * 4 + m] * sc;
#pragma unroll
                for (int bj = 0; bj < 2; ++bj) {
                    const f32x4 v0 = acc[ai][bj][m][0] * r, v1 = acc[ai][bj][m][1] * r;
                    *(GAS u32x4*)(O + (size_t)row * DM + col0 + bj * HALF) = (u32x4){cvt_pk_bf16(v0[0], v0[1]), cvt_pk_bf16(v0[2], v0[3]), cvt_pk_bf16(v1[0], v1[1]), cvt_pk_bf16(v1[2], v1[3])};
                }
            }
    }
};

template <class Epi, class Sched, bool ALIGN_EPI = false, bool SP2 = false>
__device__ __forceinline__ void gemm_phase(LAS unsigned char* lds, const Gemm g, const Sched& S, const Epi& E, const int tid) {
    const int wid = __builtin_amdgcn_readfirstlane(tid >> 6), lane = tid & 63, wr = wid >> 2, wc = wid & 3, fr = lane & 15, fq = lane >> 4;
    const int K = g.K, nt = K / BK;
    unsigned voffA[2], voffB[2];
#pragma unroll
    for (int i = 0; i < 2; ++i) { int R, C; stage_rc(tid * 16 + i * 8192, R, C); const int Rb = Epi::PERM ? ((R & ~31) + perm32(R & 31)) : R;
        voffA[i] = (unsigned)(R * K + C) * 2u; voffB[i] = (unsigned)(Rb * K + C) * 2u; }
    const size_t kstep = (size_t)(BK * 2);
    const size_t hstep = (size_t)HALF * K * 2;
    const size_t tstep = 2 * hstep;
    const unsigned ldsw = (unsigned)wid * 1024u;
    const int aoff = lds_byte(wr * 64 + fr, fq * 8), boff = lds_byte(wc * 32 + fr, fq * 8);
#define PG8_SA(b, h) (((b) * 2 + (h)) * HTB)
#define PG8_SB(b, h) ((4 + (b) * 2 + (h)) * HTB)
#define PG8_STAGE(bufoff, gbase, voff) do { _Pragma("unroll") for (int _i = 0; _i < 2; ++_i) \
        __builtin_amdgcn_global_load_lds((const unsigned*)((const char*)(gbase) + (voff)[_i]), (LAS unsigned*)(lds + (bufoff) + ldsw + _i * 8192), 16, 0, 0); } while (0)
#define PG8_LDA(dst, b, h) do { _Pragma("unroll") for (int m = 0; m < 4; ++m) _Pragma("unroll") for (int k = 0; k < 2; ++k) dst[m][k] = *(const LAS bf16x8*)(lds + PG8_SA(b, h) + aoff + m * 2048 + k * 1024); } while (0)
#define PG8_LDB(dst, b, h) do { _Pragma("unroll") for (int n = 0; n < 2; ++n) _Pragma("unroll") for (int k = 0; k < 2; ++k) dst[n][k] = *(const LAS bf16x8*)(lds + PG8_SB(b, h) + boff + n * 2048 + k * 1024); } while (0)
#define PG8_MMA(ai, bj, At, Bt) do { __builtin_amdgcn_s_setprio(1); _Pragma("unroll") for (int m = 0; m < 4; ++m) _Pragma("unroll") for (int n = 0; n < 2; ++n) _Pragma("unroll") for (int k = 0; k < 2; ++k) \
        { if constexpr (Epi::F16) acc[ai][bj][m][n] = __builtin_amdgcn_mfma_f32_16x16x32_f16(__builtin_bit_cast(f16x8, Bt[n][k]), __builtin_bit_cast(f16x8, At[m][k]), acc[ai][bj][m][n], 0, 0, 0); \
          else acc[ai][bj][m][n] = __builtin_amdgcn_mfma_f32_16x16x32_bf16(Bt[n][k], At[m][k], acc[ai][bj][m][n], 0, 0, 0); } __builtin_amdgcn_s_setprio(0); } while (0)
#define PG8_WAIT_V(n) asm volatile("s_waitcnt vmcnt(" #n ")" ::: "memory")
#define PG8_WAIT_L(n) asm volatile("s_waitcnt lgkmcnt(" #n ")" ::: "memory")
#define PG8_BAR __builtin_amdgcn_s_barrier()
#define PG8_SCHED __builtin_amdgcn_sched_barrier(0)
    Unit cur, nxt; int ui = 0;
    if (!S.next(0, cur)) return;
    f32x4 acc[2][2][4][2];
#pragma unroll
    for (int a = 0; a < 2; ++a)
#pragma unroll
        for (int b = 0; b < 2; ++b)
#pragma unroll
            for (int m = 0; m < 4; ++m)
#pragma unroll
                for (int n = 0; n < 2; ++n) acc[a][b][m][n] = (f32x4){0.f, 0.f, 0.f, 0.f};
    bf16x8 At[4][2], B0[2][2], B1[2][2];
    const char* cA = (const char*)g.A + (size_t)cur.pm * tstep; const char* cB = (const char*)g.Bt + (size_t)cur.pn * tstep;
    S.a_ready(cur);
    if constexpr (SP2) {
        PG8_STAGE(PG8_SB(0, 0), cB, voffB); PG8_STAGE(PG8_SB(0, 1), cB + hstep, voffB); PG8_STAGE(PG8_SA(0, 0), cA, voffA); PG8_STAGE(PG8_SA(0, 1), cA + hstep, voffA);
        if (wr == 1) PG8_BAR;
        PG8_WAIT_V(2); PG8_BAR;
        PG8_STAGE(PG8_SB(1, 0), cB + kstep, voffB); PG8_STAGE(PG8_SA(1, 0), cA + kstep, voffA); PG8_STAGE(PG8_SB(1, 1), cB + hstep + kstep, voffB);
        PG8_WAIT_V(6); PG8_BAR;
    } else {
        PG8_STAGE(PG8_SB(0, 0), cB, voffB); PG8_STAGE(PG8_SA(0, 0), cA, voffA); PG8_STAGE(PG8_SB(0, 1), cB + hstep, voffB); PG8_STAGE(PG8_SA(0, 1), cA + hstep, voffA);
        if (wr == 1) PG8_BAR;
        PG8_WAIT_V(4); PG8_BAR;
        PG8_STAGE(PG8_SB(1, 0), cB + kstep, voffB); PG8_STAGE(PG8_SA(1, 0), cA + kstep, voffA); PG8_STAGE(PG8_SB(1, 1), cB + hstep + kstep, voffB);
        PG8_WAIT_V(6); PG8_BAR;
    }
    for (;;) {
        const bool has_next = S.next(ui + 1, nxt);
        const char* nA = has_next ? (const char*)g.A + (size_t)nxt.pm * tstep : cA; const char* nB = has_next ? (const char*)g.Bt + (size_t)nxt.pn * tstep : cB;
        for (int t = 0; t < nt; t += 2) {
            const bool last = (t == nt - 2);
            const char* a1 = cA + (size_t)(t + 1) * kstep;
            const char* a2 = last ? nA : cA + (size_t)(t + 2) * kstep; const char* b2 = last ? nB : cB + (size_t)(t + 2) * kstep;
            const char* a3 = a2 + kstep; const char* b3 = b2 + kstep;
            if (last && has_next) S.a_ready(nxt);
            if constexpr (SP2) {
            PG8_LDB(B0, 0, 0); PG8_LDB(B1, 0, 1); PG8_SCHED; PG8_LDA(At, 0, 0); PG8_STAGE(PG8_SA(1, 1), a1 + hstep, voffA);
            PG8_WAIT_V(8); PG8_WAIT_L(0); PG8_BAR; PG8_MMA(0, 0, At, B0); PG8_MMA(0, 1, At, B1); PG8_BAR; PG8_SCHED;
            PG8_LDA(At, 0, 1); PG8_STAGE(PG8_SB(0, 0), b2, voffB); PG8_STAGE(PG8_SB(0, 1), b2 + hstep, voffB); PG8_STAGE(PG8_SA(0, 0), a2, voffA);
            PG8_WAIT_V(8); PG8_WAIT_L(0); PG8_BAR; PG8_MMA(1, 0, At, B0); PG8_MMA(1, 1, At, B1); PG8_BAR; PG8_SCHED;
            PG8_LDB(B0, 1, 0); PG8_LDB(B1, 1, 1); PG8_SCHED; PG8_LDA(At, 1, 0); PG8_STAGE(PG8_SA(0, 1), a2 + hstep, voffA);
            PG8_WAIT_V(8); PG8_WAIT_L(0); PG8_BAR; PG8_MMA(0, 0, At, B0); PG8_MMA(0, 1, At, B1); PG8_BAR; PG8_SCHED;
            PG8_LDA(At, 1, 1); PG8_STAGE(PG8_SB(1, 0), b3, voffB); PG8_STAGE(PG8_SB(1, 1), b3 + hstep, voffB); PG8_STAGE(PG8_SA(1, 0), a3, voffA);
            PG8_WAIT_V(8); PG8_WAIT_L(0); PG8_BAR; PG8_MMA(1, 0, At, B0); PG8_MMA(1, 1, At, B1); PG8_BAR; PG8_SCHED;
            } else {
            PG8_LDB(B0, 0, 0); PG8_SCHED; PG8_LDA(At, 0, 0); PG8_STAGE(PG8_SA(1, 1), a1 + hstep, voffA);
            PG8_WAIT_L(8); PG8_BAR; PG8_WAIT_L(0); PG8_MMA(0, 0, At, B0); PG8_BAR; PG8_SCHED;
            PG8_LDB(B1, 0, 1); PG8_STAGE(PG8_SB(0, 0), b2, voffB);
            PG8_BAR; PG8_WAIT_L(0); PG8_MMA(0, 1, At, B1); PG8_BAR;
            PG8_LDA(At, 0, 1); PG8_STAGE(PG8_SA(0, 0), a2, voffA);
            PG8_BAR; PG8_WAIT_L(0); PG8_MMA(1, 0, At, B0); PG8_BAR; PG8_SCHED;
            PG8_STAGE(PG8_SB(0, 1), b2 + hstep, voffB);
            PG8_WAIT_V(6); PG8_BAR; PG8_MMA(1, 1, At, B1); PG8_BAR;
            PG8_LDB(B0, 1, 0); PG8_SCHED; PG8_LDA(At, 1, 0); PG8_STAGE(PG8_SA(0, 1), a2 + hstep, voffA);
            PG8_WAIT_L(8); PG8_BAR; PG8_WAIT_L(0); PG8_MMA(0, 0, At, B0); PG8_BAR; PG8_SCHED;
            PG8_LDB(B1, 1, 1); PG8_STAGE(PG8_SB(1, 0), b3, voffB);
            PG8_BAR; PG8_WAIT_L(0); PG8_MMA(0, 1, At, B1); PG8_BAR;
            PG8_LDA(At, 1, 1); PG8_STAGE(PG8_SA(1, 0), a3, voffA);
            PG8_BAR; PG8_WAIT_L(0); PG8_MMA(1, 0, At, B0); PG8_BAR; PG8_SCHED;
            PG8_STAGE(PG8_SB(1, 1), b3 + hstep, voffB);
            PG8_WAIT_V(6); PG8_BAR; PG8_MMA(1, 1, At, B1); PG8_BAR;
            }
        }
        if constexpr (ALIGN_EPI) { if (wr == 0) PG8_BAR; }
        if constexpr (!Epi::AFTER_DRAIN) { E(acc, cur, wr, wc, fr, fq); S.done(cur); }
        if (!has_next) break;
#pragma unroll
        for (int a = 0; a < 2; ++a)
#pragma unroll
            for (int b = 0; b < 2; ++b)
#pragma unroll
                for (int m = 0; m < 4; ++m)
#pragma unroll
                    for (int n = 0; n < 2; ++n) acc[a][b][m][n] = (f32x4){0.f, 0.f, 0.f, 0.f};
        cur = nxt; cA = nA; cB = nB; ++ui;
        if constexpr (ALIGN_EPI) { if (wr == 1) PG8_BAR; }
    }
    PG8_WAIT_V(0);
    if constexpr (!ALIGN_EPI) { if (wr == 0) PG8_BAR; }
    PG8_BAR;
#undef PG8_SA
#undef PG8_SB
#undef PG8_STAGE
#undef PG8_LDA
#undef PG8_LDB
#undef PG8_MMA
#undef PG8_WAIT_V
#undef PG8_WAIT_L
#undef PG8_BAR
#undef PG8_SCHED
}
}

namespace att {
constexpr int L_K = 0, L_V = 40960, L_KB = 81920, L_BIAS = 83200, NTAB = 639, L_END = 83200 + 2560;
__device__ __forceinline__ int crow(int r, int hi) { return (r & 3) + 8 * (r >> 2) + 4 * hi; }
__device__ __forceinline__ unsigned cvtpk(float lo, float hi) { unsigned r; asm volatile("v_cvt_pk_bf16_f32 %0, %1, %2" : "=v"(r) : "v"(lo), "v"(hi)); return r; }
typedef float f32x2_t __attribute__((ext_vector_type(2))); typedef __bf16 bf16x2_t __attribute__((ext_vector_type(2)));
__device__ __forceinline__ unsigned cvtpk_c(float lo, float hi) { const f32x2_t v = {lo, hi}; const bf16x2_t b = __builtin_convertvector(v, bf16x2_t); return __builtin_bit_cast(unsigned, b); }
__device__ __forceinline__ s16x4 vtr(LAS const unsigned char* p) { return __builtin_bit_cast(s16x4, __builtin_amdgcn_ds_read_tr16_b64_v4i16((LAS s16x4*)p)); }

__device__ __forceinline__ float fadd_s(float a, float b) { float r; asm("v_add_f32_e32 %0, %1, %2" : "=v"(r) : "v"(a), "v"(b)); return r; }
__device__ __forceinline__ float fsub_s(float a, float b) { float r; asm("v_sub_f32_e32 %0, %1, %2" : "=v"(r) : "v"(a), "v"(b)); return r; }
__device__ __forceinline__ float fadd_tr(float a, float b) { float r; asm("s_nop 0\n\tv_add_f32_e32 %0, %1, %2" : "=v"(r) : "v"(a), "v"(b)); return r; }
__device__ __forceinline__ unsigned cvtpk_tr(float lo, float hi) { unsigned r; asm volatile("s_nop 0\n\tv_cvt_pk_bf16_f32 %0, %1, %2" : "=v"(r) : "v"(lo), "v"(hi)); return r; }
__device__ __forceinline__ float fadd4_tr(float acc, float a, float b, float c, float d) {
    asm("s_nop 0\n\tv_add_f32_e32 %0, %0, %1\n\tv_add_f32_e32 %0, %0, %2\n\tv_add_f32_e32 %0, %0, %3\n\tv_add_f32_e32 %0, %0, %4" : "+v"(acc) : "v"(a), "v"(b), "v"(c), "v"(d)); return acc; }
__device__ __forceinline__ void cvtpk2_tr(unsigned& r0, unsigned& r1, float a, float b, float c, float d) {
    asm volatile("s_nop 0\n\tv_cvt_pk_bf16_f32 %0, %2, %3\n\tv_cvt_pk_bf16_f32 %1, %4, %5" : "=&v"(r0), "=&v"(r1) : "v"(a), "v"(b), "v"(c), "v"(d)); }
__device__ __forceinline__ float xhalf_max(float v) { auto rr = __builtin_amdgcn_permlane32_swap(__float_as_uint(v), __float_as_uint(v), false, false); return fmaxf(__uint_as_float(rr[0]), __uint_as_float(rr[1])); }
__device__ __forceinline__ float xhalf_sum(float v) { auto rr = __builtin_amdgcn_permlane32_swap(__float_as_uint(v), __float_as_uint(v), false, false); return __uint_as_float(rr[0]) + __uint_as_float(rr[1]); }
__device__ __forceinline__ float ffma_s(float a, float b, float c) { float r; asm("v_fma_f32 %0, %1, %2, %3" : "=v"(r) : "v"(a), "v"(b), "v"(c)); return r; }
__device__ __forceinline__ void glds16(const void* gsrc, unsigned lds_dst) { unsigned keep;
    asm volatile("s_mov_b32 %0, m0\n\ts_mov_b32 m0, %2\n\ts_nop 0\n\tglobal_load_lds_dwordx4 %1, off\n\ts_mov_b32 m0, %0" : "=&s"(keep) : "v"(gsrc), "s"(lds_dst) : "memory"); }
__device__ __forceinline__ void glds4(const void* gsrc, unsigned lds_dst) { unsigned keep;
    asm volatile("s_mov_b32 %0, m0\n\ts_mov_b32 m0, %2\n\ts_nop 0\n\tglobal_load_lds_dword %1, off\n\ts_mov_b32 m0, %0" : "=&s"(keep) : "v"(gsrc), "s"(lds_dst) : "memory"); }
template <int MODE>
__device__ __forceinline__ void attn_unit(LAS unsigned char* lds, const bf16_t* Q, const bf16_t* K, const bf16_t* V, bf16_t* O, const float* aux, int b, int h, int qb, const int tid) {
    const int lane = tid & 63, wid = __builtin_amdgcn_readfirstlane(tid >> 6), r32 = lane & 31, hi = lane >> 5;
    const size_t rowbase = (size_t)b * SEQ; const int q0 = qb * 256;
    const int t_begin = MODE == 0 ? (4 * qb - 8 > 0 ? 4 * qb - 8 : 0) : 0, t_end = 4 * qb + 4, nt = t_end - t_begin;
    const int cq = 4 * qb + (wid >> 1);
    const int w_lo = MODE == 0 ? cq - 8 : 0, w_hi = cq;
    asm volatile("s_waitcnt vmcnt(0)" ::: "memory");
    const bf16_t* ksrc = K + (rowbase + lane) * DM + h * HD + wid * 8;
    const bf16_t* vsrc = V + (rowbase + 16 * (wid & 3) + (lane >> 2)) * DM + h * HD + (wid >> 2) * 32 + (lane & 3) * 8;
    const float* cum = aux + ((size_t)b * NH + h) * SEQ;
    LAS float* biasL = (LAS float*)(lds + L_BIAS);
    if (MODE == 0) { const float* tab = aux + (size_t)h * NREL; for (int i = tid; i < NTAB; i += 512) { int rel = i - 63; rel = rel < -256 ? -256 : (rel > 256 ? 256 : rel); biasL[i] = tab[rel + 256] * LOG2E; } }
    bf16x8 qr[4];
    { const bf16_t* Qw = Q + (rowbase + q0 + wid * 32 + r32) * DM + h * HD + hi * 8;
#pragma unroll
      for (int s = 0; s < 4; ++s) qr[s] = *(const bf16x8*)(Qw + s * 16); }
    float beta = 0.f;
    if (MODE == 1) beta = __builtin_bit_cast(float, __builtin_amdgcn_readfirstlane(__builtin_bit_cast(int, cum[q0 + 32 * wid + 31] * (-LOG2E))));
    const unsigned lds0 = (unsigned)(uintptr_t)lds;
    const unsigned kdst = lds0 + L_K + wid * 1024, vdst = lds0 + L_V + wid * 1024, bdst = lds0 + L_KB;
    const bool w0 = (MODE == 1) && (wid == 0);
#define ATT_DMA(tt, slot) do { glds16(ksrc + (size_t)(tt) * 64 * DM, (unsigned)__builtin_amdgcn_readfirstlane(kdst + (slot) * 8192)); \
        glds16(vsrc + (size_t)(tt) * 64 * DM, (unsigned)__builtin_amdgcn_readfirstlane(vdst + (slot) * 8192)); \
        if (w0) glds4(cum + (tt) * 64 + lane, (unsigned)__builtin_amdgcn_readfirstlane(bdst + (slot) * 256)); } while (0)
#define ATT_WAITB(n) do { const int n_ = (n); \
        if (w0) { if (n_ >= 2) asm volatile("s_waitcnt vmcnt(6) lgkmcnt(0)\n\ts_barrier" ::: "memory"); else if (n_ == 1) asm volatile("s_waitcnt vmcnt(3) lgkmcnt(0)\n\ts_barrier" ::: "memory"); else asm volatile("s_waitcnt vmcnt(0) lgkmcnt(0)\n\ts_barrier" ::: "memory"); } \
        else    { if (n_ >= 2) asm volatile("s_waitcnt vmcnt(4) lgkmcnt(0)\n\ts_barrier" ::: "memory"); else if (n_ == 1) asm volatile("s_waitcnt vmcnt(2) lgkmcnt(0)\n\ts_barrier" ::: "memory"); else asm volatile("s_waitcnt vmcnt(0) lgkmcnt(0)\n\ts_barrier" ::: "memory"); } } while (0)
#pragma unroll
    for (int k = 0; k < 4; ++k) if (k < nt) ATT_DMA(t_begin + k, k);
    ATT_WAITB(nt - 2 > 2 ? 2 : (nt - 2 < 0 ? 0 : nt - 2));
    const unsigned kfoff = hi * 1024 + r32 * 16;
    bf16x8 kf[8];
#pragma unroll
    for (int s = 0; s < 4; ++s) { kf[2 * s] = *(LAS const bf16x8*)(lds + L_K + kfoff + s * 2048); kf[2 * s + 1] = *(LAS const bf16x8*)(lds + L_K + kfoff + s * 2048 + 512); }
    float mu = 0.f, lrun = 0.f; f32x16 o0 = {}, o1 = {};
    const int qpos = q0 + wid * 32 + r32;
    const int vlane = ((lane >> 4) & 1) * 32 + (lane & 3) * 8 + (4 * hi + ((lane & 15) >> 2)) * 64;
    constexpr float THR = 12.0f;
    int cur = 0;
    for (int i = 0; i < nt; ++i) {
        const int t = t_begin + i; const int nxt = cur == 4 ? 0 : cur + 1, s4 = cur == 0 ? 4 : cur - 1;
        if (i + 4 < nt) ATT_DMA(t + 4, s4);
        const bool act = (t >= w_lo && t <= w_hi);
        f32x16 p0, p1; s16x4 vf[16];
        if (act) {
            if (MODE == 0) {
                LAS const float* bp = biasL + (qpos - 64 * t - 4 * hi + 4);
#pragma unroll
                for (int r = 0; r < 16; ++r) { const int kvl = (r & 3) + 8 * (r >> 2); p0[r] = bp[59 - kvl]; p1[r] = bp[27 - kvl]; }
                if (__any(mu != 0.f)) {
#pragma unroll
                    for (int r = 0; r < 16; ++r) { p0[r] -= mu; p1[r] -= mu; } }
            } else {
                LAS const float* kb = (LAS const float*)(lds + L_KB + cur * 256) + 4 * hi; const float noff = -(beta + mu);
#pragma unroll
                for (int g = 0; g < 4; ++g) { const f32x4 a = *(LAS const f32x4*)(kb + 8 * g), c = *(LAS const f32x4*)(kb + 32 + 8 * g);
#pragma unroll
                    for (int e = 0; e < 4; ++e) { p0[4 * g + e] = ffma_s(a[e], -LOG2E, noff); p1[4 * g + e] = ffma_s(c[e], -LOG2E, noff); } }
            }
#pragma unroll
            for (int s = 0; s < 4; ++s) {
                p0 = __builtin_amdgcn_mfma_f32_32x32x16_bf16(kf[2 * s], qr[s], p0, 0, 0, 0);
                p1 = __builtin_amdgcn_mfma_f32_32x32x16_bf16(kf[2 * s + 1], qr[s], p1, 0, 0, 0);
            }
            LAS const unsigned char* vp = lds + L_V + cur * 8192 + vlane;
#pragma unroll
            for (int s = 0; s < 4; ++s) { vf[4 * s] = vtr(vp + s * 1024); vf[4 * s + 1] = vtr(vp + s * 1024 + 512); vf[4 * s + 2] = vtr(vp + 4096 + s * 1024); vf[4 * s + 3] = vtr(vp + 4096 + s * 1024 + 512); }
        }
        if (i + 1 < nt) {
#pragma unroll
            for (int s = 0; s < 4; ++s) { kf[2 * s] = *(LAS const bf16x8*)(lds + L_K + nxt * 8192 + kfoff + s * 2048); kf[2 * s + 1] = *(LAS const bf16x8*)(lds + L_K + nxt * 8192 + kfoff + s * 2048 + 512); }
        }
        if (act) {
            if (MODE == 1 && t == cq) {
                const int kp0 = 64 * t + 4 * hi;
#pragma unroll
                for (int r = 0; r < 16; ++r) { const int kvp = kp0 + (r & 3) + 8 * (r >> 2); if (kvp > qpos) p0[r] = -1e30f; if (kvp + 32 > qpos) p1[r] = -1e30f; }
            }
            float mt = __builtin_fmaxf(__builtin_fmaxf(p0[0], p1[0]), p0[1]);
#pragma unroll
            for (int r = 1; r < 16; ++r) { if (r > 1) mt = __builtin_fmaxf(__builtin_fmaxf(mt, p0[r]), p1[r]); else mt = __builtin_fmaxf(mt, p1[1]); }
            mt = xhalf_max(mt);
            if (__any(mt > THR)) {
                const float d = fmaxf(mt, 0.f), f = __builtin_amdgcn_exp2f(-d); mu += d; lrun *= f;
#pragma unroll
                for (int r = 0; r < 16; ++r) { p0[r] -= d; p1[r] -= d; o0[r] *= f; o1[r] *= f; }
            }
#pragma unroll
            for (int r = 0; r < 16; ++r) { p0[r] = __builtin_amdgcn_exp2f(p0[r]); p1[r] = __builtin_amdgcn_exp2f(p1[r]); }
            float ls0 = 0.f, ls1 = 0.f;
#pragma unroll
            for (int r = 0; r < 16; r += 4) { ls0 = fadd4_tr(ls0, p0[r], p0[r + 1], p0[r + 2], p0[r + 3]); ls1 = fadd4_tr(ls1, p1[r], p1[r + 1], p1[r + 2], p1[r + 3]); }
            lrun = fadd_s(lrun, fadd_s(ls0, ls1));
#pragma unroll
            for (int s = 0; s < 4; ++s) {
                u32x4 pw;
                unsigned w0_, w1_, w2_, w3_;
                if (s == 0) { cvtpk2_tr(w0_, w1_, p0[0], p0[1], p0[2], p0[3]); cvtpk2_tr(w2_, w3_, p0[4], p0[5], p0[6], p0[7]); }
                else if (s == 1) { cvtpk2_tr(w0_, w1_, p0[8], p0[9], p0[10], p0[11]); cvtpk2_tr(w2_, w3_, p0[12], p0[13], p0[14], p0[15]); }
                else if (s == 2) { cvtpk2_tr(w0_, w1_, p1[0], p1[1], p1[2], p1[3]); cvtpk2_tr(w2_, w3_, p1[4], p1[5], p1[6], p1[7]); }
                else { cvtpk2_tr(w0_, w1_, p1[8], p1[9], p1[10], p1[11]); cvtpk2_tr(w2_, w3_, p1[12], p1[13], p1[14], p1[15]); }
                pw = (u32x4){w0_, w1_, w2_, w3_};
                const bf16x8 pb = __builtin_bit_cast(bf16x8, pw);
                const s16x4 a0 = vf[4 * s], a1 = vf[4 * s + 1], c0 = vf[4 * s + 2], c1 = vf[4 * s + 3];
                const bf16x8 v0 = (bf16x8){a0[0], a0[1], a0[2], a0[3], a1[0], a1[1], a1[2], a1[3]};
                const bf16x8 v1 = (bf16x8){c0[0], c0[1], c0[2], c0[3], c1[0], c1[1], c1[2], c1[3]};
                o0 = __builtin_amdgcn_mfma_f32_32x32x16_bf16(v0, pb, o0, 0, 0, 0);
                o1 = __builtin_amdgcn_mfma_f32_32x32x16_bf16(v1, pb, o1, 0, 0, 0);
            }
        }
        { const int rem = nt - i - 3; ATT_WAITB(rem > 2 ? 2 : (rem < 0 ? 0 : rem)); }
        cur = nxt;
    }
#undef ATT_DMA
#undef ATT_WAITB
    const float ltot = fmaxf(xhalf_sum(lrun), 1e-37f); const float inv = __builtin_amdgcn_rcpf(ltot);
    unsigned ox[8], oy[8];
#pragma unroll
    for (int g = 0; g < 4; ++g) {
        ox[g] = cvtpk_c(o0[4 * g] * inv, o0[4 * g + 1] * inv); oy[g] = cvtpk_c(o0[4 * g + 2] * inv, o0[4 * g + 3] * inv);
        ox[4 + g] = cvtpk_c(o1[4 * g] * inv, o1[4 * g + 1] * inv); oy[4 + g] = cvtpk_c(o1[4 * g + 2] * inv, o1[4 * g + 3] * inv);
    }
    bf16_t* Ow = O + (rowbase + q0 + wid * 32 + r32) * DM + h * HD + 8 * hi;
#pragma unroll
    for (int k = 0; k < 8; k += 2) {
        const auto rx = __builtin_amdgcn_permlane32_swap(ox[k], ox[k + 1], false, false);
        const auto ry = __builtin_amdgcn_permlane32_swap(oy[k], oy[k + 1], false, false);
        *(u32x4*)(Ow + 8 * k) = (u32x4){rx[0], ry[0], rx[1], ry[1]};
    }
}
}

__device__ __forceinline__ float wave_sum(float v) {
#pragma unroll
    for (int o = 1; o < 64; o <<= 1) v += __shfl_xor(v, o);
    return v;
}
__device__ __forceinline__ void cvt_item(const float* W, int K, int N, const float* gain, bf16_t* WT, int drow0, int k0, int n0, LAS float* scr, int lane, bool f16) {
    const int n = n0 + (lane & 31); const bool ok = n < N;
    float v[32];
    { const float* src = W + (size_t)(k0 + (lane >> 5)) * N + n;
#pragma unroll
      for (int i = 0; i < 32; ++i) v[i] = ok ? src[(size_t)(2 * i) * N] : 0.f; }
#pragma unroll
    for (int i = 0; i < 32; ++i) scr[(2 * i + (lane >> 5)) * 33 + (lane & 31)] = v[i];
    f32x4 g0 = (f32x4){1.f, 1.f, 1.f, 1.f}, g1 = g0;
    if (gain) { g0 = *(const f32x4*)(gain + k0 + 8 * (lane & 7)); g1 = *(const f32x4*)(gain + k0 + 8 * (lane & 7) + 4); }
    asm volatile("s_waitcnt lgkmcnt(0)" ::: "memory");
    const int c = lane & 7;
#pragma unroll
    for (int j = 0; j < 4; ++j) { const int nn = (lane >> 3) + 8 * j; const LAS float* s = scr + (8 * c) * 33 + nn;
        u32x4 o;
        const float e0 = s[0 * 33] * g0.x, e1 = s[1 * 33] * g0.y, e2 = s[2 * 33] * g0.z, e3 = s[3 * 33] * g0.w, e4 = s[4 * 33] * g1.x, e5 = s[5 * 33] * g1.y, e6 = s[6 * 33] * g1.z, e7 = s[7 * 33] * g1.w;
        if (f16) { o.x = pack_h2(e0, e1); o.y = pack_h2(e2, e3); o.z = pack_h2(e4, e5); o.w = pack_h2(e6, e7); }
        else { o.x = pg8::cvt_pk_bf16(e0, e1); o.y = pg8::cvt_pk_bf16(e2, e3); o.z = pg8::cvt_pk_bf16(e4, e5); o.w = pg8::cvt_pk_bf16(e6, e7); }
        *(u32x4*)(WT + (size_t)(drow0 + nn) * K + k0 + 8 * c) = o; }
    asm volatile("s_waitcnt lgkmcnt(0)" ::: "memory");
}

#define XB_TMO      128
#define XB_XCNT(j)  (256  + 64 * (j))
#define XB_XSUB(j)  (1280 + 64 * (j))
#define XB_XGEN(j)  (2304 + 64 * (j))
#define XB_TOP      3328
#define XB_TOPGEN   3392
#define XCD_BAR_WORDS 3456
#define XB_SPIN_CAP (1u << 22)
__device__ __forceinline__ unsigned xb_ld(unsigned* p)              { return __hip_atomic_load(p, __ATOMIC_RELAXED, __HIP_MEMORY_SCOPE_AGENT); }
__device__ __forceinline__ unsigned xb_add(unsigned* p, unsigned v) { return __hip_atomic_fetch_add(p, v, __ATOMIC_RELAXED, __HIP_MEMORY_SCOPE_AGENT); }
__device__ __forceinline__ unsigned xb_xcc_id() { return (unsigned)__builtin_amdgcn_s_getreg((3 << 11) | 20) & 0xFu; }
#define XB_SPIN(cond, bar) do { unsigned _sp = 0; while (cond) { __builtin_amdgcn_s_sleep(1); \
    if ((++_sp & 255u) == 0u) { if (xb_ld(&(bar)[XB_TMO])) break; if (_sp > XB_SPIN_CAP) { atomicAdd(&(bar)[XB_TMO], 1u); break; } } } } while (0)
struct XcdBarrier { unsigned* bar; unsigned x; volatile LAS unsigned* st; };
__device__ __forceinline__ XcdBarrier xcd_barrier_post(unsigned* bar, volatile LAS unsigned* st) {
    XcdBarrier b; b.bar = bar; b.x = xb_xcc_id(); b.st = st;
    if (threadIdx.x == 0) (void)xb_add(&bar[XB_XCNT(b.x)], 1u);
    return b;
}
__device__ __forceinline__ void xcd_barrier_complete(unsigned* bar, unsigned x, unsigned& nloc, unsigned& nx) {
    const unsigned G = gridDim.x * gridDim.y * gridDim.z;
    unsigned sum, cnt, mine, sp = 0u;
    for (;;) {
        sum = 0u; cnt = 0u; mine = 0u;
#pragma unroll
        for (unsigned j = 0; j < 16; ++j) { const unsigned c = xb_ld(&bar[XB_XCNT(j)]); sum += c; cnt += (c > 0u) ? 1u : 0u; mine = (j == x) ? c : mine; }
        if (sum == G) break;
        __builtin_amdgcn_s_sleep(1);
        if ((++sp & 255u) == 0u) { if (xb_ld(&bar[XB_TMO])) break; if (sp > XB_SPIN_CAP) { atomicAdd(&bar[XB_TMO], 1u); break; } }
    }
    nloc = mine > 0u ? mine : 1u; nx = cnt > 0u ? cnt : 1u;
}
__device__ __forceinline__ void xcd_barrier(const XcdBarrier& b) {
    asm volatile("s_waitcnt vmcnt(0)" ::: "memory");
    __syncthreads();
    if (threadIdx.x == 0) {
        unsigned* bar = b.bar;
        __builtin_amdgcn_s_waitcnt(0);
        unsigned nloc = b.st[0], nx = b.st[1];
        if (nloc == 0u) { xcd_barrier_complete(bar, b.x, nloc, nx); b.st[0] = nloc; b.st[1] = nx; }
        const unsigned old = xb_add(&bar[XB_XSUB(b.x)], 1u);
        const unsigned gen = old / nloc;
        if (old + 1u == (gen + 1u) * nloc) {
            __builtin_amdgcn_fence(__ATOMIC_RELEASE, "agent");
            asm volatile("s_waitcnt vmcnt(0)" ::: "memory");
            const unsigned og = xb_add(&bar[XB_TOP], 1u);
            const unsigned tg = og / nx;
            if (og + 1u == (tg + 1u) * nx) xb_add(&bar[XB_TOPGEN], 1u);
            else XB_SPIN(xb_ld(&bar[XB_TOPGEN]) == tg, bar);
            __builtin_amdgcn_fence(__ATOMIC_ACQUIRE, "agent");
            xb_add(&bar[XB_XGEN(b.x)], 1u);
            asm volatile("s_waitcnt vmcnt(0)" ::: "memory");
        } else {
            XB_SPIN(xb_ld(&bar[XB_XGEN(b.x)]) == gen, bar);
            __builtin_amdgcn_fence(__ATOMIC_ACQUIRE, "agent");
            asm volatile("s_waitcnt vmcnt(0)" ::: "memory");
        }
    }
    __syncthreads();
}

#define GB_CNT(g)   (3456 + 64 * (g))
#define GB_MASK(g)  (4096 + 64 * (g))
#define BAR_ZERO_WORDS 4608
__device__ __forceinline__ void group_barrier(unsigned* bar, unsigned g, unsigned nmem) {
    asm volatile("s_waitcnt vmcnt(0)" ::: "memory");
    __syncthreads();
    if (threadIdx.x == 0) {
        __builtin_amdgcn_s_waitcnt(0);
        const unsigned old = xb_add(&bar[GB_CNT(g)], 1u);
        const unsigned target = (old / nmem + 1u) * nmem;
        XB_SPIN(xb_ld(&bar[GB_CNT(g)]) < target, bar);
        __builtin_amdgcn_fence(__ATOMIC_ACQUIRE, "agent");
        asm volatile("s_waitcnt vmcnt(0)" ::: "memory");
    }
    __syncthreads();
}

struct Args { const float* in[15]; float* out; unsigned char* ws; };

#ifndef PROBE_A2
#define PROBE_A2 0
#endif
#ifndef PROBE_B2
#define PROBE_B2 0
#endif
#ifndef PROBE_P2
#define PROBE_P2 0
#endif
#ifndef PROBE_GU2
#define PROBE_GU2 0
#endif
#ifndef PROBE_RS2
#define PROBE_RS2 0
#endif
#ifndef PROBE_PJ2
#define PROBE_PJ2 0
#endif
#ifndef PROBE_S2
#define PROBE_S2 0
#endif
constexpr int NTHREADS = 512;
constexpr int LDS_BYTES = 151552;
constexpr int RSTD_OFF = 131072 + 1024;
constexpr int MISC_OFF = 131072 + 320;

__global__ void __launch_bounds__(NTHREADS, 2) yoco_fwd(Args args) {
    extern __shared__ __attribute__((aligned(16))) unsigned char lds_raw[];
    LAS unsigned char* lds = (LAS unsigned char*)lds_raw;
    cg::grid_group grid = cg::this_grid();
    const int tid = threadIdx.x, lane = tid & 63, wave = __builtin_amdgcn_readfirstlane(tid >> 6);
    constexpr int G = 256; const int bx = blockIdx.x;
    unsigned char* ws = args.ws;
    const float* x = args.in[0]; const float* ffn_norm = args.in[1]; const float* w_gate = args.in[2]; const float* w_up = args.in[3]; const float* w_down = args.in[4];
    const float* mix_norm = args.in[5]; const float* a_w_qkv = args.in[6]; const float* a_w_o = args.in[7]; const float* a_rel_bias = args.in[8];
    const float* kv_norm = args.in[9]; const float* b_w_kvf = args.in[10]; const float* b_f_bias = args.in[11]; const float* b_w_q = args.in[12]; const float* b_w_o = args.in[13];
    const float* final_norm = args.in[14];
    float* hout = args.out;

    unsigned* barw = (unsigned*)(ws + WS_BAR);
    volatile LAS unsigned* MISC = (volatile LAS unsigned*)(lds + MISC_OFF);
    if (tid < 2) MISC[tid] = 0u;
    if (bx == 0) for (int i = tid; i < BAR_ZERO_WORDS; i += NTHREADS) __hip_atomic_store(barw + i, 0u, __ATOMIC_RELAXED, __HIP_MEMORY_SCOPE_AGENT);
    {
        LAS float* scr = (LAS float*)(lds + wave * 16384);
        float* ssq = (float*)(ws + WS_SSQ); bf16_t* hb = (bf16_t*)(ws + WS_HB);
        const int gw = bx * 8 + wave, NGW = G * 8;
        constexpr int I_G = (DM / 64) * (FF / 32), I_D = (FF / 64) * (DM / 32), I_FFN = 2 * I_G + I_D;
        constexpr int I_QKV = (DM / 64) * (3 * DM / 32), I_SQ = (DM / 64) * (DM / 32), I_KVF = (DM / 64) * 65;
        constexpr int NITEMS = 8 * I_FFN + 2 * I_QKV + 2 * I_SQ + I_KVF + 2 * I_SQ + 2 * I_SQ;
        for (int rep = 0; rep < 1 + PROBE_P2; ++rep)
        for (int it = gw; it < NITEMS; it += NGW) {
            int r = it;
            if (r < 8 * I_FFN) {
                const int idx = r / I_FFN; r -= idx * I_FFN; bf16_t* wgu = (bf16_t*)(ws + WS_W + idx * W_FFN_BLK); bf16_t* wd = (bf16_t*)(ws + WS_W + idx * W_FFN_BLK + W_GU_BYTES);
                if (r < 2 * I_G) { const int s = r / I_G; r -= s * I_G; const int nblk = FF / 32, kb = r / nblk, nb = r % nblk, n0 = nb * 32;
                    cvt_item((s ? w_up : w_gate) + (size_t)idx * DM * FF, DM, FF, ffn_norm + idx * DM, wgu, 256 * (n0 >> 7) + 128 * s + (n0 & 127), kb * 64, n0, scr, lane, true); }
                else { r -= 2 * I_G; const int nblk = DM / 32, kb = r / nblk, nb = r % nblk; cvt_item(w_down + (size_t)idx * FF * DM, FF, DM, nullptr, wd, nb * 32, kb * 64, nb * 32, scr, lane, false); }
                continue;
            }
            r -= 8 * I_FFN;
            if (r < 2 * I_QKV) { const int la = r / I_QKV; r -= la * I_QKV; const int nblk = 3 * DM / 32, kb = r / nblk, nb = r % nblk;
                cvt_item(a_w_qkv + (size_t)la * DM * 3 * DM, DM, 3 * DM, mix_norm + la * DM, (bf16_t*)(ws + WS_WQKV) + (size_t)la * 3 * DM * DM, nb * 32, kb * 64, nb * 32, scr, lane, true); continue; }
            r -= 2 * I_QKV;
            if (r < 2 * I_SQ) { const int la = r / I_SQ; r -= la * I_SQ; const int nblk = DM / 32, kb = r / nblk, nb = r % nblk;
                cvt_item(a_w_o + (size_t)la * DM * DM, DM, DM, nullptr, (bf16_t*)(ws + WS_WAO) + (size_t)la * DM * DM, nb * 32, kb * 64, nb * 32, scr, lane, false); continue; }
            r -= 2 * I_SQ;
            if (r < I_KVF) { const int nblk = 65, kb = r / nblk, nb = r % nblk;
                cvt_item(b_w_kvf, DM, 2 * DM + NH, kv_norm, (bf16_t*)(ws + WS_WKVF), nb * 32, kb * 64, nb * 32, scr, lane, true); continue; }
            r -= I_KVF;
            if (r < 2 * I_SQ) { const int lb = r / I_SQ; r -= lb * I_SQ; const int nblk = DM / 32, kb = r / nblk, nb = r % nblk;
                cvt_item(b_w_q + (size_t)lb * DM * DM, DM, DM, mix_norm + (2 + lb) * DM, (bf16_t*)(ws + WS_WBQ) + (size_t)lb * DM * DM, nb * 32, kb * 64, nb * 32, scr, lane, true); continue; }
            r -= 2 * I_SQ;
            { const int lb = r / I_SQ; r -= lb * I_SQ; const int nblk = DM / 32, kb = r / nblk, nb = r % nblk;
                cvt_item(b_w_o + (size_t)lb * DM * DM, DM, DM, nullptr, (bf16_t*)(ws + WS_WBO) + (size_t)lb * DM * DM, nb * 32, kb * 64, nb * 32, scr, lane, false); }
        }
        for (int m = gw; m < TOK; m += NGW) {
            const f32x4* xr = (const f32x4*)(x + (size_t)m * DM) + lane; f32x4 v[4]; float s = 0.f;
#pragma unroll
            for (int j = 0; j < 4; ++j) v[j] = xr[64 * j];
            u32x2* o8 = (u32x2*)(hb + (size_t)m * DM) + lane;
#pragma unroll
            for (int j = 0; j < 4; ++j) { const u32x2 w = (u32x2){pack_h2(v[j].x, v[j].y), pack_h2(v[j].z, v[j].w)}; o8[64 * j] = w;
                const float r0 = h_lo(w.x), r1 = h_hi(w.x), r2 = h_lo(w.y), r3 = h_hi(w.y); s += (r0 * r0 + r1 * r1) + (r2 * r2 + r3 * r3); }
            s = wave_sum(s);
            if (lane < 16) ssq[(size_t)m * 16 + lane] = lane == 0 ? s : 0.f;
        }
    }
    __syncthreads();
    grid.sync();
    const XcdBarrier xb = xcd_barrier_post(barw, MISC);
    const int grp = bx & 7, gj = bx >> 3; constexpr int GJ = G >> 3;
    if (tid == 0) __hip_atomic_fetch_or(barw + GB_MASK(grp), 1u << xb.x, __ATOMIC_RELAXED, __HIP_MEMORY_SCOPE_AGENT);
    bool use_group = false;

#pragma unroll 1
    for (int opi = 0; opi < 58; ++opi) {
        const int op = opi >> 1, rep = opi & 1;
        unsigned char* wsv = args.ws; asm volatile("" : "+s"(wsv));
        float* ssq = (float*)(wsv + WS_SSQ); float* flog = (float*)(wsv + WS_FLOG); float* cum = (float*)(wsv + WS_CUM);
        bf16_t* hb = (bf16_t*)(wsv + WS_HB);
        bf16_t* Rq = (bf16_t*)(wsv + WS_R + (size_t)(bx & 7) * (16 * MiB)); bf16_t* Rk = Rq + (size_t)SEQ * DM; bf16_t* Rv = Rk + (size_t)SEQ * DM;
        bf16_t* mid = (bf16_t*)(wsv + WS_R + (size_t)(bx & 7) * (2 * MiB));
        bf16_t* Ksh = (bf16_t*)(wsv + WS_KSH); bf16_t* Vsh = (bf16_t*)(wsv + WS_VSH);
        unsigned char* ws = wsv;
        int tidv = threadIdx.x; asm volatile("" : "+v"(tidv));
        int l, j;
        if (op < 14) { l = op / 7; j = op % 7; } else if (op == 14) { l = 2; j = 7; } else { l = 2 + (op - 15) / 7; j = (op - 15) % 7; }
        const bool dbl = (PROBE_GU2 && (j == 0 || j == 5)) || (PROBE_RS2 && (j == 1 || j == 6 || j == 4)) || (PROBE_PJ2 && (j == 2 || j == 7));
        if (rep == 0 && !dbl) continue;
        const int p = j >= 5 ? 1 : 0;
        const int idx = l * 2 + p;
        const LAS float* rstdL = (const LAS float*)(lds + RSTD_OFF);
        if (j == 0 || j == 5 || j == 2 || j == 7) {
            const GAS float* sp = (const GAS float*)ssq + ((size_t)grp * SEQ + tidv * 8) * 16;
#pragma unroll
            for (int r = 0; r < 8; ++r) { const f32x4 a = *(const GAS f32x4*)(sp + r * 16), b2 = *(const GAS f32x4*)(sp + r * 16 + 4), c = *(const GAS f32x4*)(sp + r * 16 + 8), d = *(const GAS f32x4*)(sp + r * 16 + 12);
                const float ssum = ((a.x + a.y) + (a.z + a.w)) + ((b2.x + b2.y) + (b2.z + b2.w)) + ((c.x + c.y) + (c.z + c.w)) + ((d.x + d.y) + (d.z + d.w));
                ((LAS float*)(lds + RSTD_OFF))[tidv * 8 + r] = __builtin_amdgcn_rsqf(ssum * (1.0f / DM) + EPS); }
            __syncthreads();
        }
        if (j == 0 || j == 5) {
            pg8::Gemm g{hb, (const bf16_t*)(ws + WS_W + idx * W_FFN_BLK), TOK, 2 * FF, DM}; pg8::StaticOrder S; S.init(TOK, 2 * FF, G, bx);
            pg8::EpiSwiglu E{mid, rstdL, grp * SEQ};
            pg8::gemm_phase<pg8::EpiSwiglu, pg8::StaticOrder, true, true>(lds, g, S, E, tidv);
        } else if (j == 1 || j == 6 || j == 4) {
            if (op == 16 && gj < NH) {
                const int b = grp, hh = gj; const float* src = flog + ((size_t)b * SEQ + tid * 8) * 16 + hh; float v[8];
#pragma unroll
                for (int i = 0; i < 8; ++i) v[i] = src[(size_t)i * 16];
#pragma unroll
                for (int i = 1; i < 8; ++i) v[i] += v[i - 1];
                float incl = v[7];
#pragma unroll
                for (int o = 1; o < 64; o <<= 1) { const float t2 = __shfl_up(incl, o); if (lane >= o) incl += t2; }
                volatile LAS float* wtot = (volatile LAS float*)(lds + MISC_OFF + 64);
                if (lane == 63) wtot[wave] = incl;
                __syncthreads();
                float base = incl - v[7];
                for (int w = 0; w < wave; ++w) base += wtot[w];
                float* dst = cum + ((size_t)b * NH + hh) * SEQ + tid * 8;
                *(f32x4*)dst = (f32x4){base + v[0], base + v[1], base + v[2], base + v[3]}; *(f32x4*)(dst + 4) = (f32x4){base + v[4], base + v[5], base + v[6], base + v[7]};
            }
            const bool isO = (j == 4);
            const bf16_t* A = isO ? Rq : mid;
            const bf16_t* Bt = isO ? (l < 2 ? (const bf16_t*)(ws + WS_WAO) + (size_t)l * DM * DM : (const bf16_t*)(ws + WS_WBO) + (size_t)(l - 2) * DM * DM)
                                   : (const bf16_t*)(ws + WS_W + idx * W_FFN_BLK + W_GU_BYTES);
            pg8::Gemm g{A, Bt, TOK, DM, isO ? DM : FF}; pg8::StaticOrder S; S.init(TOK, DM, G, bx);
            pg8::EpiResid E{hb, ssq, (dbl && rep == 0) ? 0.0f : (isO ? 1.0f : 0.5f)};
            pg8::gemm_phase<pg8::EpiResid, pg8::StaticOrder, true, true>(lds, g, S, E, tidv);
        } else if (j == 2 || j == 7) {
            const bf16_t* Bt; int N; bf16_t* O0; long ostr; float sc; float* fl = nullptr;
            if (j == 7) { Bt = (const bf16_t*)(ws + WS_WKVF); N = 2304; O0 = Ksh; ostr = (long)((WS_VSH - WS_KSH) / 2); sc = 1.0f; fl = flog; }
            else if (l < 2) { Bt = (const bf16_t*)(ws + WS_WQKV) + (size_t)l * 3 * DM * DM; N = 3 * DM; O0 = Rq; ostr = (long)SEQ * DM; sc = QSCALE; }
            else { Bt = (const bf16_t*)(ws + WS_WBQ) + (size_t)(l - 2) * DM * DM; N = DM; O0 = Rq; ostr = 0; sc = QSCALE; }
            pg8::Gemm g{hb, Bt, TOK, N, DM}; pg8::StaticOrder S; S.init(TOK, N, G, bx);
            pg8::EpiProj E{O0, ostr, rstdL, grp * SEQ, sc, fl, b_f_bias};
            pg8::gemm_phase<pg8::EpiProj, pg8::StaticOrder, true, true>(lds, g, S, E, tidv);
        } else {
            if (l < 2) {
                for (int v = gj; v < NH * 16; v += GJ) { const int hh = v & 15, qb = v >> 4;
                    if (PROBE_A2) att::attn_unit<0>(lds, Rq, Rk, Rv, Vsh, a_rel_bias + (size_t)l * NH * NREL, grp, hh, qb, tidv);
                    att::attn_unit<0>(lds, Rq, Rk, Rv, Rq, a_rel_bias + (size_t)l * NH * NREL, grp, hh, qb, tidv); }
            } else {
                for (int i = 0; i < 8; ++i) { const int hh = 4 * (gj >> 3) + (i >> 1), sidx = gj & 7, qb = (i & 1) ? 15 - sidx : sidx;
                    if (PROBE_B2) att::attn_unit<1>(lds, Rq, Ksh, Vsh, Rk, cum, grp, hh, qb, tidv);
                    att::attn_unit<1>(lds, Rq, Ksh, Vsh, Rq, cum, grp, hh, qb, tidv); }
            }
        }
        if (op != 14) {
            if (use_group && op != 13) group_barrier(barw, (unsigned)grp, (unsigned)GJ);
            else { xcd_barrier(xb);
                if (op == 0) {
                    bool ok = true;
#pragma unroll
                    for (int g = 0; g < 8; ++g) { const unsigned mk = xb_ld(barw + GB_MASK(g)); ok = ok && (mk != 0u) && ((mk & (mk - 1u)) == 0u); }
                    use_group = ok && !PROBE_S2; } }
        }
    }

    {
        const bf16_t* hb = (const bf16_t*)(ws + WS_HB);
        for (int r = gj * 8 + wave; r < SEQ; r += GJ * 8) { const int m = grp * SEQ + r;
            const u32x2* hr = (const u32x2*)(hb + (size_t)m * DM) + lane; f32x4* xr = (f32x4*)(hout + (size_t)m * DM) + lane; const f32x4* gr = (const f32x4*)final_norm + lane; f32x4 v[4]; float s = 0.f;
#pragma unroll
            for (int jj = 0; jj < 4; ++jj) { const u32x2 w = hr[64 * jj]; v[jj] = (f32x4){h_lo(w.x), h_hi(w.x), h_lo(w.y), h_hi(w.y)}; s += (v[jj].x * v[jj].x + v[jj].y * v[jj].y) + (v[jj].z * v[jj].z + v[jj].w * v[jj].w); }
            const float rs = rsqrtf(wave_sum(s) * (1.0f / DM) + EPS);
#pragma unroll
            for (int jj = 0; jj < 4; ++jj) __builtin_nontemporal_store(v[jj] * rs * gr[64 * jj], xr + 64 * jj);
        }
    }
}

extern "C" void kernel_launch(void* const* d_in, const int* in_sizes, int n_in, void* d_out, int out_size, void* d_ws, size_t ws_size, hipStream_t stream) {
    static int grid = 0;
    if (grid == 0) {
        if (n_in != 15 || out_size != TOK * DM || ws_size < WS_END) { fprintf(stderr, "kernel_launch: unexpected shapes (n_in %d out %d ws %zu)\n", n_in, out_size, ws_size); grid = -1; return; }
        int dev = 0, cus = 0, per_cu = 0;
        hipGetDevice(&dev); hipDeviceGetAttribute(&cus, hipDeviceAttributeMultiprocessorCount, dev);
        if (hipFuncSetAttribute((const void*)yoco_fwd, hipFuncAttributeMaxDynamicSharedMemorySize, LDS_BYTES) != hipSuccess) { fprintf(stderr, "kernel_launch: hipFuncSetAttribute failed\n"); grid = -1; return; }
        if (hipOccupancyMaxActiveBlocksPerMultiprocessor(&per_cu, (const void*)yoco_fwd, NTHREADS, LDS_BYTES) != hipSuccess || per_cu < 1) { fprintf(stderr, "kernel_launch: occupancy query says %d\n", per_cu); per_cu = 1; }
        (void)hipGetLastError();
        if (cus < 256) fprintf(stderr, "kernel_launch: this kernel needs 256 CUs (device reports %d)\n", cus);
        grid = 256;
    }
    if (grid < 0) return;
    Args a{};
    for (int i = 0; i < 15; ++i) a.in[i] = (const float*)d_in[i];
    a.out = (float*)d_out; a.ws = (unsigned char*)d_ws;
    void* kargs[] = {&a};
    hipError_t e = hipLaunchCooperativeKernel((const void*)yoco_fwd, dim3(grid), dim3(NTHREADS), kargs, LDS_BYTES, stream);
    if (e != hipSuccess) fprintf(stderr, "cooperative launch failed: %s (grid %d)\n", hipGetErrorString(e), grid);
}
```

```cpp
#include <hip/hip_runtime.h>
#include <hip/hip_cooperative_groups.h>
#include <cstdio>
#include <cstdint>
namespace cg = cooperative_groups;

#define LAS __attribute__((address_space(3)))
typedef unsigned short bf16_t;
typedef short bf16x8 __attribute__((ext_vector_type(8)));
typedef short s16x4 __attribute__((ext_vector_type(4)));
typedef float f32x4 __attribute__((ext_vector_type(4)));
typedef float f32x16 __attribute__((ext_vector_type(16)));
typedef unsigned u32x4 __attribute__((ext_vector_type(4)));
typedef unsigned u32x2 __attribute__((ext_vector_type(2)));
typedef _Float16 f16x8 __attribute__((ext_vector_type(8)));
typedef _Float16 f16x2 __attribute__((ext_vector_type(2)));
__device__ __forceinline__ unsigned pack_h2(float a, float b) { const f16x2 v = {(_Float16)a, (_Float16)b}; return __builtin_bit_cast(unsigned, v); }
__device__ __forceinline__ float h_lo(unsigned w) { return (float)__builtin_bit_cast(f16x2, w).x; }
__device__ __forceinline__ float h_hi(unsigned w) { return (float)__builtin_bit_cast(f16x2, w).y; }

constexpr int BATCH = 8, SEQ = 4096, DM = 1024, NH = 16, HD = 64, FF = 2816, TOK = BATCH * SEQ, NREL = 513;
constexpr float EPS = 1e-6f;
constexpr float LOG2E = 1.4426950408889634f;
constexpr float QSCALE = 0.125f * LOG2E;

constexpr size_t MiB = 1u << 20;
constexpr size_t WS_SSQ = 0;
constexpr size_t WS_FLOG = 2 * MiB;
constexpr size_t WS_CUM = 4 * MiB;
constexpr size_t WS_BAR = 6 * MiB;
constexpr size_t WS_W = 8 * MiB;
constexpr size_t W_FFN_BLK = (size_t)(2 * FF * DM + DM * FF) * 2;
constexpr size_t W_GU_BYTES = (size_t)2 * FF * DM * 2;
constexpr size_t WS_WQKV = WS_W + 8 * W_FFN_BLK;
constexpr size_t WS_WAO = WS_WQKV + 2 * (size_t)3 * DM * DM * 2;
constexpr size_t WS_WKVF = WS_WAO + 2 * (size_t)DM * DM * 2;
constexpr size_t WS_WBQ = WS_WKVF + (size_t)2304 * DM * 2;
constexpr size_t WS_WBO = WS_WBQ + 2 * (size_t)DM * DM * 2;
constexpr size_t WS_WEND = WS_WBO + 2 * (size_t)DM * DM * 2;
constexpr size_t WS_HB = 169 * MiB;
constexpr size_t WS_R = 233 * MiB;
constexpr size_t WS_VSH = 425 * MiB;
constexpr size_t WS_KSH = WS_W;
constexpr size_t WS_END = 489 * MiB;
static_assert(WS_WEND <= WS_HB, "weights overflow");
static_assert(4 * W_FFN_BLK >= (size_t)TOK * DM * 2, "K_sh overlay must fit in the layer 0/1 FFN weights");
static_assert((size_t)SEQ * FF * 2 <= 24 * MiB && 3 * (size_t)SEQ * DM * 2 <= 24 * MiB && 8 * 24 * MiB <= WS_VSH - WS_R, "per-batch regions fit R");

namespace pg8 {
constexpr int BM = 256, BK = 64, HALF = 128, HTB = HALF * BK * 2, STAGE_BYTES = 8 * HTB, NXCD = 8, WGM = 4;
__host__ __device__ __forceinline__ int lds_byte(int r, int c) { const int st = (r >> 4) * 2 + (c >> 5), rr = r & 15, cc = c & 31, ob = rr * 64 + cc * 2; return st * 1024 + (ob ^ (((ob >> 9) & 1) << 5)); }
__host__ __device__ __forceinline__ void stage_rc(int b, int& R, int& C) { const int st = b / 1024, sb = b % 1024, swz = sb ^ (((sb >> 9) & 1) << 5); R = (st >> 1) * 16 + swz / 64; C = (st & 1) * 32 + (swz % 64) / 2; }
__host__ __device__ __forceinline__ int perm32(int rho) { const int n = rho >> 4, i = rho & 15; return 8 * (i >> 2) + 4 * n + (i & 3); }

struct Unit { int pm, pn; };
struct Gemm { const bf16_t* A; const bf16_t* Bt; int M, N, K; };

struct StaticOrder {
    int nM, nN, nwg, G, c;
    __host__ __device__ void init(int M, int N, int G_, int c_) { nM = M / BM; nN = N / BM; nwg = nM * nN; G = G_; c = c_; }
    __host__ __device__ bool next(int i, Unit& u) const {
        const long L = (long)i * G + c; if (L >= nwg) return false;
        int wgid = (int)L; { const int q = nwg / NXCD, r = nwg % NXCD, xcd = wgid % NXCD, off = wgid / NXCD; wgid = (xcd < r ? xcd * (q + 1) : r * (q + 1) + (xcd - r) * q) + off; }
        const int nig = WGM * nN, gid = wgid / nig, fm = gid * WGM, gsz = (nM - fm) < WGM ? (nM - fm) : WGM;
        u.pm = fm + ((wgid % nig) % gsz); u.pn = (wgid % nig) / gsz; return true;
    }
    __device__ __forceinline__ void a_ready(const Unit&) const {}
    __device__ __forceinline__ void done(const Unit&) const {}
};

__device__ __forceinline__ unsigned cvt_pk_bf16(float lo, float hi) { unsigned r; asm volatile("v_cvt_pk_bf16_f32 %0, %1, %2" : "=v"(r) : "v"(lo), "v"(hi)); return r; }

__device__ __forceinline__ float fq_sum(float v) {
    auto a = __builtin_amdgcn_permlane16_swap(__float_as_uint(v), __float_as_uint(v), false, false); v = __uint_as_float(a[0]) + __uint_as_float(a[1]);
    auto b = __builtin_amdgcn_permlane32_swap(__float_as_uint(v), __float_as_uint(v), false, false); return __uint_as_float(b[0]) + __uint_as_float(b[1]);
}
#define GAS __attribute__((address_space(1)))
__device__ __forceinline__ float fmul_s(float a, float b) { float r; asm("v_mul_f32_e32 %0, %1, %2" : "=v"(r) : "v"(a), "v"(b)); return r; }
__device__ __forceinline__ float row_rstd(const GAS float* ssq, int row, int fq) {
    const f32x4 pp = *(const GAS f32x4*)(ssq + (size_t)row * 16 + 4 * fq);
    const float s = fq_sum((pp.x + pp.y) + (pp.z + pp.w));
    return __builtin_amdgcn_rsqf(s * (1.0f / DM) + EPS);
}

struct EpiSwiglu {
    static constexpr bool PERM = true, AFTER_DRAIN = false, F16 = true;
    bf16_t* O; const LAS float* rstd; int rowbase;
    __device__ __forceinline__ void operator()(const f32x4 (&acc)[2][2][4][2], const Unit& u, int wr, int wc, int fr, int fq) const {
        const int row0 = u.pm * BM + wr * 64 + fr, col0 = u.pn * HALF + wc * 32 + 8 * fq;
        GAS bf16_t* O_g = (GAS bf16_t*)O;
        float rs[8];
#pragma unroll
        for (int i = 0; i < 8; ++i) rs[i] = rstd[row0 + (i >> 2) * HALF + (i & 3) * 16 - rowbase];
#pragma unroll
        for (int ai = 0; ai < 2; ++ai)
#pragma unroll
            for (int m = 0; m < 4; ++m) {
                const int row = row0 + ai * HALF + m * 16; const float r = rs[ai * 4 + m], nrl = -r * LOG2E, rs2 = r * r;
                unsigned w[4];
#pragma unroll
                for (int n = 0; n < 2; ++n) {
                    const f32x4 g = acc[ai][0][m][n], up = acc[ai][1][m][n];
                    const f32x4 t = g * nrl; f32x4 ex, sg;
#pragma unroll
                    for (int e = 0; e < 4; ++e) ex[e] = __builtin_amdgcn_exp2f(t[e]);
                    const f32x4 d = ex + 1.0f;
#pragma unroll
                    for (int e = 0; e < 4; ++e) sg[e] = __builtin_amdgcn_rcpf(d[e]);
                    const f32x4 y = (g * up) * (sg * rs2);
                    w[2 * n] = cvt_pk_bf16(y[0], y[1]); w[2 * n + 1] = cvt_pk_bf16(y[2], y[3]);
                }
                *(GAS u32x4*)(O_g + (size_t)row * FF + col0) = (u32x4){w[0], w[1], w[2], w[3]};
            }
    }
};

__device__ __forceinline__ float bf_lo(unsigned w) { return __uint_as_float(w << 16); }
__device__ __forceinline__ float bf_hi(unsigned w) { return __uint_as_float(w & 0xffff0000u); }
struct EpiResid {
    static constexpr bool PERM = true, AFTER_DRAIN = false, F16 = false;
    bf16_t* hb; float* ssq; float alpha;
    __device__ __forceinline__ void operator()(const f32x4 (&acc)[2][2][4][2], const Unit& u, int wr, int wc, int fr, int fq) const {
        const int row0 = u.pm * BM + wr * 64 + fr, col0 = u.pn * BM + wc * 32 + 8 * fq;
        GAS bf16_t* hb_g = (GAS bf16_t*)hb; GAS float* ssq_g = (GAS float*)ssq;
        u32x4 bv[8][2];
#pragma unroll
        for (int q = 0; q < 4; ++q)
#pragma unroll
            for (int bj = 0; bj < 2; ++bj) bv[q][bj] = *(const GAS u32x4*)(hb_g + (size_t)(row0 + (q >> 2) * HALF + (q & 3) * 16) * DM + col0 + bj * HALF);
#pragma unroll
        for (int q = 0; q < 8; ++q) {
            const int ai = q >> 2, m = q & 3;
            const int row = row0 + ai * HALF + m * 16; float ss = 0.f;
#pragma unroll
            for (int bj = 0; bj < 2; ++bj) {
                const size_t off = (size_t)row * DM + col0 + bj * HALF;
                const u32x4 b = bv[q][bj];
                const f32x4 a0 = acc[ai][bj][m][0] * alpha, a1 = acc[ai][bj][m][1] * alpha;
                u32x4 o;
                o.x = pack_h2(h_lo(b.x) + a0[0], h_hi(b.x) + a0[1]); o.y = pack_h2(h_lo(b.y) + a0[2], h_hi(b.y) + a0[3]);
                o.z = pack_h2(h_lo(b.z) + a1[0], h_hi(b.z) + a1[1]); o.w = pack_h2(h_lo(b.w) + a1[2], h_hi(b.w) + a1[3]);
                *(GAS u32x4*)(hb_g + off) = o;
                const float r0 = h_lo(o.x), r1 = h_hi(o.x), r2 = h_lo(o.y), r3 = h_hi(o.y), r4 = h_lo(o.z), r5 = h_hi(o.z), r6 = h_lo(o.w), r7 = h_hi(o.w);
                ss += (r0 * r0 + r1 * r1) + (r2 * r2 + r3 * r3) + (r4 * r4 + r5 * r5) + (r6 * r6 + r7 * r7);
            }
            if (q + 4 < 8) {
#pragma unroll
                for (int bj = 0; bj < 2; ++bj) bv[q + 4][bj] = *(const GAS u32x4*)(hb_g + (size_t)(row0 + ((q + 4) >> 2) * HALF + ((q + 4) & 3) * 16) * DM + col0 + bj * HALF);
            }
            ss = fq_sum(ss);
            if (fq == 0) ssq_g[(size_t)row * 16 + u.pn * 4 + wc] = ss;
        }
    }
};

struct EpiProj {
    static constexpr bool PERM = true, AFTER_DRAIN = false, F16 = true;
    bf16_t* O0; long ostride; const LAS float* rstd; int rowbase; float scale0; float* flog; const float* bf;
    __device__ __forceinline__ void operator()(const f32x4 (&acc)[2][2][4][2], const Unit& u, int wr, int wc, int fr, int fq) const {
        const int row0 = u.pm * BM + wr * 64 + fr; const int t = u.pn >> 2, pnl = u.pn & 3;
        float rs[8];
#pragma unroll
        for (int i = 0; i < 8; ++i) rs[i] = rstd[row0 + (i >> 2) * HALF + (i & 3) * 16 - rowbase];
        if (t == 2 && flog) {
            GAS float* flog_g = (GAS float*)flog; const GAS float* bf_g = (const GAS float*)bf;
            if (wc == 0 && fq < 2) {
                const f32x4 b0 = *(const GAS f32x4*)(bf_g + 8 * fq), b1 = *(const GAS f32x4*)(bf_g + 8 * fq + 4);
#pragma unroll
                for (int ai = 0; ai < 2; ++ai)
#pragma unroll
                    for (int m = 0; m < 4; ++m) {
                        const int row = row0 + ai * HALF + m * 16; const float r = rs[ai * 4 + m]; f32x4 o[2];
#pragma unroll
                        for (int n = 0; n < 2; ++n)
#pragma unroll
                            for (int e = 0; e < 4; ++e) { const float x = acc[ai][0][m][n][e] * r + (n == 0 ? b0[e] : b1[e]);
                                o[n][e] = fminf(x, 0.f) - 0.6931471805599453f * __builtin_amdgcn_logf(1.0f + __builtin_amdgcn_exp2f(-fabsf(x) * LOG2E)); }
                        *(GAS f32x4*)(flog_g + (size_t)row * 16 + 8 * fq) = o[0]; *(GAS f32x4*)(flog_g + (size_t)row * 16 + 8 * fq + 4) = o[1];
                    }
            }
            return;
        }
        GAS bf16_t* O = (GAS bf16_t*)O0 + (long)t * ostride; const float sc = t == 0 ? scale0 : 1.0f;
        const int col0 = pnl * BM + wc * 32 + 8 * fq;
#pragma unroll
        for (int ai = 0; ai < 2; ++ai)
#pragma unroll
            for (int m = 0; m < 4; ++m) {
                const int row = row0 + ai * HALF + m * 16; const float r = rs[ai * 4 + m] * sc;
#pragma unroll
                for (int bj = 0; bj < 2; ++bj) {
                    const f32x4 v0 = acc[ai][bj][m][0] * r, v1 = acc[ai][bj][m][1] * r;
                    *(GAS u32x4*)(O + (size_t)row * DM + col0 + bj * HALF) = (u32x4){cvt_pk_bf16(v0[0], v0[1]), cvt_pk_bf16(v0[2], v0[3]), cvt_pk_bf16(v1[0], v1[1]), cvt_pk_bf16(v1[2], v1[3])};
                }
            }
    }
};

template <class Epi, class Sched, bool ALIGN_EPI = false, bool SP2 = false>
__device__ __forceinline__ void gemm_phase(LAS unsigned char* lds, const Gemm g, const Sched& S, const Epi& E, const int tid) {
    const int wid = __builtin_amdgcn_readfirstlane(tid >> 6), lane = tid & 63, wr = wid >> 2, wc = wid & 3, fr = lane & 15, fq = lane >> 4;
    const int K = g.K, nt = K / BK;
    unsigned voffA[2], voffB[2];
#pragma unroll
    for (int i = 0; i < 2; ++i) { int R, C; stage_rc(tid * 16 + i * 8192, R, C); const int Rb = Epi::PERM ? ((R & ~31) + perm32(R & 31)) : R;
        voffA[i] = (unsigned)(R * K + C) * 2u; voffB[i] = (unsigned)(Rb * K + C) * 2u; }
    const size_t kstep = (size_t)(BK * 2);
    const size_t hstep = (size_t)HALF * K * 2;
    const size_t tstep = 2 * hstep;
    const unsigned ldsw = (unsigned)wid * 1024u;
    const int aoff = lds_byte(wr * 64 + fr, fq * 8), boff = lds_byte(wc * 32 + fr, fq * 8);
#define PG8_SA(b, h) (((b) * 2 + (h)) * HTB)
#define PG8_SB(b, h) ((4 + (b) * 2 + (h)) * HTB)
#define PG8_STAGE(bufoff, gbase, voff) do { _Pragma("unroll") for (int _i = 0; _i < 2; ++_i) \
        __builtin_amdgcn_global_load_lds((const unsigned*)((const char*)(gbase) + (voff)[_i]), (LAS unsigned*)(lds + (bufoff) + ldsw + _i * 8192), 16, 0, 0); } while (0)
#define PG8_LDA(dst, b, h) do { _Pragma("unroll") for (int m = 0; m < 4; ++m) _Pragma("unroll") for (int k = 0; k < 2; ++k) dst[m][k] = *(const LAS bf16x8*)(lds + PG8_SA(b, h) + aoff + m * 2048 + k * 1024); } while (0)
#define PG8_LDB(dst, b, h) do { _Pragma("unroll") for (int n = 0; n < 2; ++n) _Pragma("unroll") for (int k = 0; k < 2; ++k) dst[n][k] = *(const LAS bf16x8*)(lds + PG8_SB(b, h) + boff + n * 2048 + k * 1024); } while (0)
#define PG8_MMA(ai, bj, At, Bt) do { __builtin_amdgcn_s_setprio(1); _Pragma("unroll") for (int m = 0; m < 4; ++m) _Pragma("unroll") for (int n = 0; n < 2; ++n) _Pragma("unroll") for (int k = 0; k < 2; ++k) \
        { if constexpr (Epi::F16) acc[ai][bj][m][n] = __builtin_amdgcn_mfma_f32_16x16x32_f16(__builtin_bit_cast(f16x8, Bt[n][k]), __builtin_bit_cast(f16x8, At[m][k]), acc[ai][bj][m][n], 0, 0, 0); \
          else acc[ai][bj][m][n] = __builtin_amdgcn_mfma_f32_16x16x32_bf16(Bt[n][k], At[m][k], acc[ai][bj][m][n], 0, 0, 0); } __builtin_amdgcn_s_setprio(0); } while (0)
#define PG8_WAIT_V(n) asm volatile("s_waitcnt vmcnt(" #n ")" ::: "memory")
#define PG8_WAIT_L(n) asm volatile("s_waitcnt lgkmcnt(" #n ")" ::: "memory")
#define PG8_BAR __builtin_amdgcn_s_barrier()
#define PG8_SCHED __builtin_amdgcn_sched_barrier(0)
    Unit cur, nxt; int ui = 0;
    if (!S.next(0, cur)) return;
    f32x4 acc[2][2][4][2];
#pragma unroll
    for (int a = 0; a < 2; ++a)
#pragma unroll
        for (int b = 0; b < 2; ++b)
#pragma unroll
            for (int m = 0; m < 4; ++m)
#pragma unroll
                for (int n = 0; n < 2; ++n) acc[a][b][m][n] = (f32x4){0.f, 0.f, 0.f, 0.f};
    bf16x8 At[4][2], B0[2][2], B1[2][2];
    const char* cA = (const char*)g.A + (size_t)cur.pm * tstep; const char* cB = (const char*)g.Bt + (size_t)cur.pn * tstep;
    S.a_ready(cur);
    if constexpr (SP2) {
        PG8_STAGE(PG8_SB(0, 0), cB, voffB); PG8_STAGE(PG8_SB(0, 1), cB + hstep, voffB); PG8_STAGE(PG8_SA(0, 0), cA, voffA); PG8_STAGE(PG8_SA(0, 1), cA + hstep, voffA);
        if (wr == 1) PG8_BAR;
        PG8_WAIT_V(2); PG8_BAR;
        PG8_STAGE(PG8_SB(1, 0), cB + kstep, voffB); PG8_STAGE(PG8_SA(1, 0), cA + kstep, voffA); PG8_STAGE(PG8_SB(1, 1), cB + hstep + kstep, voffB);
        PG8_WAIT_V(6); PG8_BAR;
    } else {
        PG8_STAGE(PG8_SB(0, 0), cB, voffB); PG8_STAGE(PG8_SA(0, 0), cA, voffA); PG8_STAGE(PG8_SB(0, 1), cB + hstep, voffB); PG8_STAGE(PG8_SA(0, 1), cA + hstep, voffA);
        if (wr == 1) PG8_BAR;
        PG8_WAIT_V(4); PG8_BAR;
        PG8_STAGE(PG8_SB(1, 0), cB + kstep, voffB); PG8_STAGE(PG8_SA(1, 0), cA + kstep, voffA); PG8_STAGE(PG8_SB(1, 1), cB + hstep + kstep, voffB);
        PG8_WAIT_V(6); PG8_BAR;
    }
    for (;;) {
        const bool has_next = S.next(ui + 1, nxt);
        const char* nA = has_next ? (const char*)g.A + (size_t)nxt.pm * tstep : cA; const char* nB = has_next ? (const char*)g.Bt + (size_t)nxt.pn * tstep : cB;
        for (int t = 0; t < nt; t += 2) {
            const bool last = (t == nt - 2);
            const char* a1 = cA + (size_t)(t + 1) * kstep;
            const char* a2 = last ? nA : cA + (size_t)(t + 2) * kstep; const char* b2 = last ? nB : cB + (size_t)(t + 2) * kstep;
            const char* a3 = a2 + kstep; const char* b3 = b2 + kstep;
            if (last && has_next) S.a_ready(nxt);
            if constexpr (SP2) {
            PG8_LDB(B0, 0, 0); PG8_LDB(B1, 0, 1); PG8_SCHED; PG8_LDA(At, 0, 0); PG8_STAGE(PG8_SA(1, 1), a1 + hstep, voffA);
            PG8_WAIT_V(8); PG8_WAIT_L(0); PG8_BAR; PG8_MMA(0, 0, At, B0); PG8_MMA(0, 1, At, B1); PG8_BAR; PG8_SCHED;
            PG8_LDA(At, 0, 1); PG8_STAGE(PG8_SB(0, 0), b2, voffB); PG8_STAGE(PG8_SB(0, 1), b2 + hstep, voffB); PG8_STAGE(PG8_SA(0, 0), a2, voffA);
            PG8_WAIT_V(8); PG8_WAIT_L(0); PG8_BAR; PG8_MMA(1, 0, At, B0); PG8_MMA(1, 1, At, B1); PG8_BAR; PG8_SCHED;
            PG8_LDB(B0, 1, 0); PG8_LDB(B1, 1, 1); PG8_SCHED; PG8_LDA(At, 1, 0); PG8_STAGE(PG8_SA(0, 1), a2 + hstep, voffA);
            PG8_WAIT_V(8); PG8_WAIT_L(0); PG8_BAR; PG8_MMA(0, 0, At, B0); PG8_MMA(0, 1, At, B1); PG8_BAR; PG8_SCHED;
            PG8_LDA(At, 1, 1); PG8_STAGE(PG8_SB(1, 0), b3, voffB); PG8_STAGE(PG8_SB(1, 1), b3 + hstep, voffB); PG8_STAGE(PG8_SA(1, 0), a3, voffA);
            PG8_WAIT_V(8); PG8_WAIT_L(0); PG8_BAR; PG8_MMA(1, 0, At, B0); PG8_MMA(1, 1, At, B1); PG8_BAR; PG8_SCHED;
            } else {
            PG8_LDB(B0, 0, 0); PG8_SCHED; PG8_LDA(At, 0, 0); PG8_STAGE(PG8_SA(1, 1), a1 + hstep, voffA);
            PG8_WAIT_L(8); PG8_BAR; PG8_WAIT_L(0); PG8_MMA(0, 0, At, B0); PG8_BAR; PG8_SCHED;
            PG8_LDB(B1, 0, 1); PG8_STAGE(PG8_SB(0, 0), b2, voffB);
            PG8_BAR; PG8_WAIT_L(0); PG8_MMA(0, 1, At, B1); PG8_BAR;
            PG8_LDA(At, 0, 1); PG8_STAGE(PG8_SA(0, 0), a2, voffA);
            PG8_BAR; PG8_WAIT_L(0); PG8_MMA(1, 0, At, B0); PG8_BAR; PG8_SCHED;
            PG8_STAGE(PG8_SB(0, 1), b2 + hstep, voffB);
            PG8_WAIT_V(6); PG8_BAR; PG8_MMA(1, 1, At, B1); PG8_BAR;
            PG8_LDB(B0, 1, 0); PG8_SCHED; PG8_LDA(At, 1, 0); PG8_STAGE(PG8_SA(0, 1), a2 + hstep, voffA);
            PG8_WAIT_L(8); PG8_BAR; PG8_WAIT_L(0); PG8_MMA(0, 0, At, B0); PG8_BAR; PG8_SCHED;
            PG8_LDB(B1, 1, 1); PG8_STAGE(PG8_SB(1, 0), b3, voffB);
            PG8_BAR; PG8_WAIT_L(0); PG8_MMA(0, 1, At, B1); PG8_BAR;
            PG8_LDA(At, 1, 1); PG8_STAGE(PG8_SA(1, 0), a3, voffA);
            PG8_BAR; PG8_WAIT_L(0); PG8_MMA(1, 0, At, B0); PG8_BAR; PG8_SCHED;
            PG8_STAGE(PG8_SB(1, 1), b3 + hstep, voffB);
            PG8_WAIT_V(6); PG8_BAR; PG8_MMA(1, 1, At, B1); PG8_BAR;
            }
        }
        if constexpr (ALIGN_EPI) { if (wr == 0) PG8_BAR; }
        if constexpr (!Epi::AFTER_DRAIN) { E(acc, cur, wr, wc, fr, fq); S.done(cur); }
        if (!has_next) break;
#pragma unroll
        for (int a = 0; a < 2; ++a)
#pragma unroll
            for (int b = 0; b < 2; ++b)
#pragma unroll
                for (int m = 0; m < 4; ++m)
#pragma unroll
                    for (int n = 0; n < 2; ++n) acc[a][b][m][n] = (f32x4){0.f, 0.f, 0.f, 0.f};
        cur = nxt; cA = nA; cB = nB; ++ui;
        if constexpr (ALIGN_EPI) { if (wr == 1) PG8_BAR; }
    }
    PG8_WAIT_V(0);
    if constexpr (!ALIGN_EPI) { if (wr == 0) PG8_BAR; }
    PG8_BAR;
#undef PG8_SA
#undef PG8_SB
#undef PG8_STAGE
#undef PG8_LDA
#undef PG8_LDB
#undef PG8_MMA
#undef PG8_WAIT_V
#undef PG8_WAIT_L
#undef PG8_BAR
#undef PG8_SCHED
}
}

namespace att {
constexpr int L_K = 0, L_V = 40960, L_KB = 81920, L_BIAS = 83200, NTAB = 639, L_END = 83200 + 2560;
__device__ __forceinline__ int crow(int r, int hi) { return (r & 3) + 8 * (r >> 2) + 4 * hi; }
__device__ __forceinline__ unsigned cvtpk(float lo, float hi) { unsigned r; asm volatile("v_cvt_pk_bf16_f32 %0, %1, %2" : "=v"(r) : "v"(lo), "v"(hi)); return r; }
typedef float f32x2_t __attribute__((ext_vector_type(2))); typedef __bf16 bf16x2_t __attribute__((ext_vector_type(2)));
__device__ __forceinline__ unsigned cvtpk_c(float lo, float hi) { const f32x2_t v = {lo, hi}; const bf16x2_t b = __builtin_convertvector(v, bf16x2_t); return __builtin_bit_cast(unsigned, b); }
__device__ __forceinline__ s16x4 vtr(LAS const unsigned char* p) { return __builtin_bit_cast(s16x4, __builtin_amdgcn_ds_read_tr16_b64_v4i16((LAS s16x4*)p)); }

__device__ __forceinline__ float fadd_s(float a, float b) { float r; asm("v_add_f32_e32 %0, %1, %2" : "=v"(r) : "v"(a), "v"(b)); return r; }
__device__ __forceinline__ float fsub_s(float a, float b) { float r; asm("v_sub_f32_e32 %0, %1, %2" : "=v"(r) : "v"(a), "v"(b)); return r; }
__device__ __forceinline__ float fadd_tr(float a, float b) { float r; asm("s_nop 0\n\tv_add_f32_e32 %0, %1, %2" : "=v"(r) : "v"(a), "v"(b)); return r; }
__device__ __forceinline__ unsigned cvtpk_tr(float lo, float hi) { unsigned r; asm volatile("s_nop 0\n\tv_cvt_pk_bf16_f32 %0, %1, %2" : "=v"(r) : "v"(lo), "v"(hi)); return r; }
__device__ __forceinline__ float fadd4_tr(float acc, float a, float b, float c, float d) {
    asm("s_nop 0\n\tv_add_f32_e32 %0, %0, %1\n\tv_add_f32_e32 %0, %0, %2\n\tv_add_f32_e32 %0, %0, %3\n\tv_add_f32_e32 %0, %0, %4" : "+v"(acc) : "v"(a), "v"(b), "v"(c), "v"(d)); return acc; }
__device__ __forceinline__ void cvtpk2_tr(unsigned& r0, unsigned& r1, float a, float b, float c, float d) {
    asm volatile("s_nop 0\n\tv_cvt_pk_bf16_f32 %0, %2, %3\n\tv_cvt_pk_bf16_f32 %1, %4, %5" : "=&v"(r0), "=&v"(r1) : "v"(a), "v"(b), "v"(c), "v"(d)); }
__device__ __forceinline__ float xhalf_max(float v) { auto rr = __builtin_amdgcn_permlane32_swap(__float_as_uint(v), __float_as_uint(v), false, false); return fmaxf(__uint_as_float(rr[0]), __uint_as_float(rr[1])); }
__device__ __forceinline__ float xhalf_sum(float v) { auto rr = __builtin_amdgcn_permlane32_swap(__float_as_uint(v), __float_as_uint(v), false, false); return __uint_as_float(rr[0]) + __uint_as_float(rr[1]); }
__device__ __forceinline__ float ffma_s(float a, float b, float c) { float r; asm("v_fma_f32 %0, %1, %2, %3" : "=v"(r) : "v"(a), "v"(b), "v"(c)); return r; }
__device__ __forceinline__ void glds16(const void* gsrc, unsigned lds_dst) { unsigned keep;
    asm volatile("s_mov_b32 %0, m0\n\ts_mov_b32 m0, %2\n\ts_nop 0\n\tglobal_load_lds_dwordx4 %1, off\n\ts_mov_b32 m0, %0" : "=&s"(keep) : "v"(gsrc), "s"(lds_dst) : "memory"); }
__device__ __forceinline__ void glds4(const void* gsrc, unsigned lds_dst) { unsigned keep;
    asm volatile("s_mov_b32 %0, m0\n\ts_mov_b32 m0, %2\n\ts_nop 0\n\tglobal_load_lds_dword %1, off\n\ts_mov_b32 m0, %0" : "=&s"(keep) : "v"(gsrc), "s"(lds_dst) : "memory"); }
template <int MODE>
__device__ __forceinline__ void attn_unit(LAS unsigned char* lds, const bf16_t* Q, const bf16_t* K, const bf16_t* V, bf16_t* O, const float* aux, int b, int h, int qb, const int tid) {
    const int lane = tid & 63, wid = __builtin_amdgcn_readfirstlane(tid >> 6), r32 = lane & 31, hi = lane >> 5;
    const size_t rowbase = (size_t)b * SEQ; const int q0 = qb * 256;
    const int t_begin = MODE == 0 ? (4 * qb - 8 > 0 ? 4 * qb - 8 : 0) : 0, t_end = 4 * qb + 4, nt = t_end - t_begin;
    const int cq = 4 * qb + (wid >> 1);
    const int w_lo = MODE == 0 ? cq - 8 : 0, w_hi = cq;
    asm volatile("s_waitcnt vmcnt(0)" ::: "memory");
    const bf16_t* ksrc = K + (rowbase + lane) * DM + h * HD + wid * 8;
    const bf16_t* vsrc = V + (rowbase + 16 * (wid & 3) + (lane >> 2)) * DM + h * HD + (wid >> 2) * 32 + (lane & 3) * 8;
    const float* cum = aux + ((size_t)b * NH + h) * SEQ;
    LAS float* biasL = (LAS float*)(lds + L_BIAS);
    if (MODE == 0) { const float* tab = aux + (size_t)h * NREL; for (int i = tid; i < NTAB; i += 512) { int rel = i - 63; rel = rel < -256 ? -256 : (rel > 256 ? 256 : rel); biasL[i] = tab[rel + 256] * LOG2E; } }
    bf16x8 qr[4];
    { const bf16_t* Qw = Q + (rowbase + q0 + wid * 32 + r32) * DM + h * HD + hi * 8;
#pragma unroll
      for (int s = 0; s < 4; ++s) qr[s] = *(const bf16x8*)(Qw + s * 16); }
    float beta = 0.f;
    if (MODE == 1) beta = __builtin_bit_cast(float, __builtin_amdgcn_readfirstlane(__builtin_bit_cast(int, cum[q0 + 32 * wid + 31] * (-LOG2E))));
    const unsigned lds0 = (unsigned)(uintptr_t)lds;
    const unsigned kdst = lds0 + L_K + wid * 1024, vdst = lds0 + L_V + wid * 1024, bdst = lds0 + L_KB;
    const bool w0 = (MODE == 1) && (wid == 0);
#define ATT_DMA(tt, slot) do { glds16(ksrc + (size_t)(tt) * 64 * DM, (unsigned)__builtin_amdgcn_readfirstlane(kdst + (slot) * 8192)); \
        glds16(vsrc + (size_t)(tt) * 64 * DM, (unsigned)__builtin_amdgcn_readfirstlane(vdst + (slot) * 8192)); \
        if (w0) glds4(cum + (tt) * 64 + lane, (unsigned)__builtin_amdgcn_readfirstlane(bdst + (slot) * 256)); } while (0)
#define ATT_WAITB(n) do { const int n_ = (n); \
        if (w0) { if (n_ >= 2) asm volatile("s_waitcnt vmcnt(6) lgkmcnt(0)\n\ts_barrier" ::: "memory"); else if (n_ == 1) asm volatile("s_waitcnt vmcnt(3) lgkmcnt(0)\n\ts_barrier" ::: "memory"); else asm volatile("s_waitcnt vmcnt(0) lgkmcnt(0)\n\ts_barrier" ::: "memory"); } \
        else    { if (n_ >= 2) asm volatile("s_waitcnt vmcnt(4) lgkmcnt(0)\n\ts_barrier" ::: "memory"); else if (n_ == 1) asm volatile("s_waitcnt vmcnt(2) lgkmcnt(0)\n\ts_barrier" ::: "memory"); else asm volatile("s_waitcnt vmcnt(0) lgkmcnt(0)\n\ts_barrier" ::: "memory"); } } while (0)
#pragma unroll
    for (int k = 0; k < 4; ++k) if (k < nt) ATT_DMA(t_begin + k, k);
    ATT_WAITB(nt - 2 > 2 ? 2 : (nt - 2 < 0 ? 0 : nt - 2));
    const unsigned kfoff = hi * 1024 + r32 * 16;
    bf16x8 kf[8];
#pragma unroll
    for (int s = 0; s < 4; ++s) { kf[2 * s] = *(LAS const bf16x8*)(lds + L_K + kfoff + s * 2048); kf[2 * s + 1] = *(LAS const bf16x8*)(lds + L_K + kfoff + s * 2048 + 512); }
    float mu = 0.f, lrun = 0.f; f32x16 o0 = {}, o1 = {};
    const int qpos = q0 + wid * 32 + r32;
    const int vlane = ((lane >> 4) & 1) * 32 + (lane & 3) * 8 + (4 * hi + ((lane & 15) >> 2)) * 64;
    constexpr float THR = 12.0f;
    int cur = 0;
    for (int i = 0; i < nt; ++i) {
        const int t = t_begin + i; const int nxt = cur == 4 ? 0 : cur + 1, s4 = cur == 0 ? 4 : cur - 1;
        if (i + 4 < nt) ATT_DMA(t + 4, s4);
        const bool act = (t >= w_lo && t <= w_hi);
        f32x16 p0, p1; s16x4 vf[16];
        if (act) {
            if (MODE == 0) {
                LAS const float* bp = biasL + (qpos - 64 * t - 4 * hi + 4);
#pragma unroll
                for (int r = 0; r < 16; ++r) { const int kvl = (r & 3) + 8 * (r >> 2); p0[r] = bp[59 - kvl]; p1[r] = bp[27 - kvl]; }
                if (__any(mu != 0.f)) {
#pragma unroll
                    for (int r = 0; r < 16; ++r) { p0[r] -= mu; p1[r] -= mu; } }
            } else {
                LAS const float* kb = (LAS const float*)(lds + L_KB + cur * 256) + 4 * hi; const float noff = -(beta + mu);
#pragma unroll
                for (int g = 0; g < 4; ++g) { const f32x4 a = *(LAS const f32x4*)(kb + 8 * g), c = *(LAS const f32x4*)(kb + 32 + 8 * g);
#pragma unroll
                    for (int e = 0; e < 4; ++e) { p0[4 * g + e] = ffma_s(a[e], -LOG2E, noff); p1[4 * g + e] = ffma_s(c[e], -LOG2E, noff); } }
            }
#pragma unroll
            for (int s = 0; s < 4; ++s) {
                p0 = __builtin_amdgcn_mfma_f32_32x32x16_bf16(kf[2 * s], qr[s], p0, 0, 0, 0);
                p1 = __builtin_amdgcn_mfma_f32_32x32x16_bf16(kf[2 * s + 1], qr[s], p1, 0, 0, 0);
            }
            LAS const unsigned char* vp = lds + L_V + cur * 8192 + vlane;
#pragma unroll
            for (int s = 0; s < 4; ++s) { vf[4 * s] = vtr(vp + s * 1024); vf[4 * s + 1] = vtr(vp + s * 1024 + 512); vf[4 * s + 2] = vtr(vp + 4096 + s * 1024); vf[4 * s + 3] = vtr(vp + 4096 + s * 1024 + 512); }
        }
        if (i + 1 < nt) {
#pragma unroll
            for (int s = 0; s < 4; ++s) { kf[2 * s] = *(LAS const bf16x8*)(lds + L_K + nxt * 8192 + kfoff + s * 2048); kf[2 * s + 1] = *(LAS const bf16x8*)(lds + L_K + nxt * 8192 + kfoff + s * 2048 + 512); }
        }
        if (act) {
            if (MODE == 1 && t == cq) {
                const int kp0 = 64 * t + 4 * hi;
#pragma unroll
                for (int r = 0; r < 16; ++r) { const int kvp = kp0 + (r & 3) + 8 * (r >> 2); if (kvp > qpos) p0[r] = -1e30f; if (kvp + 32 > qpos) p1[r] = -1e30f; }
            }
            float mt = __builtin_fmaxf(__builtin_fmaxf(p0[0], p1[0]), p0[1]);
#pragma unroll
            for (int r = 1; r < 16; ++r) { if (r > 1) mt = __builtin_fmaxf(__builtin_fmaxf(mt, p0[r]), p1[r]); else mt = __builtin_fmaxf(mt, p1[1]); }
            mt = xhalf_max(mt);
            if (__any(mt > THR)) {
                const float d = fmaxf(mt, 0.f), f = __builtin_amdgcn_exp2f(-d); mu += d; lrun *= f;
#pragma unroll
                for (int r = 0; r < 16; ++r) { p0[r] -= d; p1[r] -= d; o0[r] *= f; o1[r] *= f; }
            }
#pragma unroll
            for (int r = 0; r < 16; ++r) { p0[r] = __builtin_amdgcn_exp2f(p0[r]); p1[r] = __builtin_amdgcn_exp2f(p1[r]); }
            float ls0 = 0.f, ls1 = 0.f;
#pragma unroll
            for (int r = 0; r < 16; r += 4) { ls0 = fadd4_tr(ls0, p0[r], p0[r + 1], p0[r + 2], p0[r + 3]); ls1 = fadd4_tr(ls1, p1[r], p1[r + 1], p1[r + 2], p1[r + 3]); }
            lrun = fadd_s(lrun, fadd_s(ls0, ls1));
#pragma unroll
            for (int s = 0; s < 4; ++s) {
                u32x4 pw;
                unsigned w0_, w1_, w2_, w3_;
                if (s == 0) { cvtpk2_tr(w0_, w1_, p0[0], p0[1], p0[2], p0[3]); cvtpk2_tr(w2_, w3_, p0[4], p0[5], p0[6], p0[7]); }
                else if (s == 1) { cvtpk2_tr(w0_, w1_, p0[8], p0[9], p0[10], p0[11]); cvtpk2_tr(w2_, w3_, p0[12], p0[13], p0[14], p0[15]); }
                else if (s == 2) { cvtpk2_tr(w0_, w1_, p1[0], p1[1], p1[2], p1[3]); cvtpk2_tr(w2_, w3_, p1[4], p1[5], p1[6], p1[7]); }
                else { cvtpk2_tr(w0_, w1_, p1[8], p1[9], p1[10], p1[11]); cvtpk2_tr(w2_, w3_, p1[12], p1[13], p1[14], p1[15]); }
                pw = (u32x4){w0_, w1_, w2_, w3_};
                const bf16x8 pb = __builtin_bit_cast(bf16x8, pw);
                const s16x4 a0 = vf[4 * s], a1 = vf[4 * s + 1], c0 = vf[4 * s + 2], c1 = vf[4 * s + 3];
                const bf16x8 v0 = (bf16x8){a0[0], a0[1], a0[2], a0[3], a1[0], a1[1], a1[2], a1[3]};
                const bf16x8 v1 = (bf16x8){c0[0], c0[1], c0[2], c0[3], c1[0], c1[1], c1[2], c1[3]};
                o0 = __builtin_amdgcn_mfma_f32_32x32x16_bf16(v0, pb, o0, 0, 0, 0);
                o1 = __builtin_amdgcn_mfma_f32_32x32x16_bf16(v1, pb, o1, 0, 0, 0);
            }
        }
        { const int rem = nt - i - 3; ATT_WAITB(rem > 2 ? 2 : (rem < 0 ? 0 : rem)); }
        cur = nxt;
    }
#undef ATT_DMA
#undef ATT_WAITB
    const float ltot = fmaxf(xhalf_sum(lrun), 1e-37f); const float inv = __builtin_amdgcn_rcpf(ltot);
    unsigned ox[8], oy[8];
#pragma unroll
    for (int g = 0; g < 4; ++g) {
        ox[g] = cvtpk_c(o0[4 * g] * inv, o0[4 * g + 1] * inv); oy[g] = cvtpk_c(o0[4 * g + 2] * inv, o0[4 * g + 3] * inv);
        ox[4 + g] = cvtpk_c(o1[4 * g] * inv, o1[4 * g + 1] * inv); oy[4 + g] = cvtpk_c(o1[4 * g + 2] * inv, o1[4 * g + 3] * inv);
    }
    bf16_t* Ow = O + (rowbase + q0 + wid * 32 + r32) * DM + h * HD + 8 * hi;
#pragma unroll
    for (int k = 0; k < 8; k += 2) {
        const auto rx = __builtin_amdgcn_permlane32_swap(ox[k], ox[k + 1], false, false);
        const auto ry = __builtin_amdgcn_permlane32_swap(oy[k], oy[k + 1], false, false);
        *(u32x4*)(Ow + 8 * k) = (u32x4){rx[0], ry[0], rx[1], ry[1]};
    }
}
}

__device__ __forceinline__ float wave_sum(float v) {
#pragma unroll
    for (int o = 1; o < 64; o <<= 1) v += __shfl_xor(v, o);
    return v;
}
__device__ __forceinline__ void cvt_item(const float* W, int K, int N, const float* gain, bf16_t* WT, int drow0, int k0, int n0, LAS float* scr, int lane, bool f16) {
    const int n = n0 + (lane & 31); const bool ok = n < N;
    float v[32];
    { const float* src = W + (size_t)(k0 + (lane >> 5)) * N + n;
#pragma unroll
      for (int i = 0; i < 32; ++i) v[i] = ok ? src[(size_t)(2 * i) * N] : 0.f; }
#pragma unroll
    for (int i = 0; i < 32; ++i) scr[(2 * i + (lane >> 5)) * 33 + (lane & 31)] = v[i];
    f32x4 g0 = (f32x4){1.f, 1.f, 1.f, 1.f}, g1 = g0;
    if (gain) { g0 = *(const f32x4*)(gain + k0 + 8 * (lane & 7)); g1 = *(const f32x4*)(gain + k0 + 8 * (lane & 7) + 4); }
    asm volatile("s_waitcnt lgkmcnt(0)" ::: "memory");
    const int c = lane & 7;
#pragma unroll
    for (int j = 0; j < 4; ++j) { const int nn = (lane >> 3) + 8 * j; const LAS float* s = scr + (8 * c) * 33 + nn;
        u32x4 o;
        const float e0 = s[0 * 33] * g0.x, e1 = s[1 * 33] * g0.y, e2 = s[2 * 33] * g0.z, e3 = s[3 * 33] * g0.w, e4 = s[4 * 33] * g1.x, e5 = s[5 * 33] * g1.y, e6 = s[6 * 33] * g1.z, e7 = s[7 * 33] * g1.w;
        if (f16) { o.x = pack_h2(e0, e1); o.y = pack_h2(e2, e3); o.z = pack_h2(e4, e5); o.w = pack_h2(e6, e7); }
        else { o.x = pg8::cvt_pk_bf16(e0, e1); o.y = pg8::cvt_pk_bf16(e2, e3); o.z = pg8::cvt_pk_bf16(e4, e5); o.w = pg8::cvt_pk_bf16(e6, e7); }
        *(u32x4*)(WT + (size_t)(drow0 + nn) * K + k0 + 8 * c) = o; }
    asm volatile("s_waitcnt lgkmcnt(0)" ::: "memory");
}

#define XB_TMO      128
#define XB_XCNT(j)  (256  + 64 * (j))
#define XB_XSUB(j)  (1280 + 64 * (j))
#define XB_XGEN(j)  (2304 + 64 * (j))
#define XB_TOP      3328
#define XB_TOPGEN   3392
#define XCD_BAR_WORDS 3456
#define XB_SPIN_CAP (1u << 22)
__device__ __forceinline__ unsigned xb_ld(unsigned* p)              { return __hip_atomic_load(p, __ATOMIC_RELAXED, __HIP_MEMORY_SCOPE_AGENT); }
__device__ __forceinline__ unsigned xb_add(unsigned* p, unsigned v) { return __hip_atomic_fetch_add(p, v, __ATOMIC_RELAXED, __HIP_MEMORY_SCOPE_AGENT); }
__device__ __forceinline__ unsigned xb_xcc_id() { return (unsigned)__builtin_amdgcn_s_getreg((3 << 11) | 20) & 0xFu; }
#define XB_SPIN(cond, bar) do { unsigned _sp = 0; while (cond) { __builtin_amdgcn_s_sleep(1); \
    if ((++_sp & 255u) == 0u) { if (xb_ld(&(bar)[XB_TMO])) break; if (_sp > XB_SPIN_CAP) { atomicAdd(&(bar)[XB_TMO], 1u); break; } } } } while (0)
struct XcdBarrier { unsigned* bar; unsigned x; volatile LAS unsigned* st; };
__device__ __forceinline__ XcdBarrier xcd_barrier_post(unsigned* bar, volatile LAS unsigned* st) {
    XcdBarrier b; b.bar = bar; b.x = xb_xcc_id(); b.st = st;
    if (threadIdx.x == 0) (void)xb_add(&bar[XB_XCNT(b.x)], 1u);
    return b;
}
__device__ __forceinline__ void xcd_barrier_complete(unsigned* bar, unsigned x, unsigned& nloc, unsigned& nx) {
    const unsigned G = gridDim.x * gridDim.y * gridDim.z;
    unsigned sum, cnt, mine, sp = 0u;
    for (;;) {
        sum = 0u; cnt = 0u; mine = 0u;
#pragma unroll
        for (unsigned j = 0; j < 16; ++j) { const unsigned c = xb_ld(&bar[XB_XCNT(j)]); sum += c; cnt += (c > 0u) ? 1u : 0u; mine = (j == x) ? c : mine; }
        if (sum == G) break;
        __builtin_amdgcn_s_sleep(1);
        if ((++sp & 255u) == 0u) { if (xb_ld(&bar[XB_TMO])) break; if (sp > XB_SPIN_CAP) { atomicAdd(&bar[XB_TMO], 1u); break; } }
    }
    nloc = mine > 0u ? mine : 1u; nx = cnt > 0u ? cnt : 1u;
}
__device__ __forceinline__ void xcd_barrier(const XcdBarrier& b) {
    asm volatile("s_waitcnt vmcnt(0)" ::: "memory");
    __syncthreads();
    if (threadIdx.x == 0) {
        unsigned* bar = b.bar;
        __builtin_amdgcn_s_waitcnt(0);
        unsigned nloc = b.st[0], nx = b.st[1];
        if (nloc == 0u) { xcd_barrier_complete(bar, b.x, nloc, nx); b.st[0] = nloc; b.st[1] = nx; }
        const unsigned old = xb_add(&bar[XB_XSUB(b.x)], 1u);
        const unsigned gen = old / nloc;
        if (old + 1u == (gen + 1u) * nloc) {
            __builtin_amdgcn_fence(__ATOMIC_RELEASE, "agent");
            asm volatile("s_waitcnt vmcnt(0)" ::: "memory");
            const unsigned og = xb_add(&bar[XB_TOP], 1u);
            const unsigned tg = og / nx;
            if (og + 1u == (tg + 1u) * nx) xb_add(&bar[XB_TOPGEN], 1u);
            else XB_SPIN(xb_ld(&bar[XB_TOPGEN]) == tg, bar);
            __builtin_amdgcn_fence(__ATOMIC_ACQUIRE, "agent");
            xb_add(&bar[XB_XGEN(b.x)], 1u);
            asm volatile("s_waitcnt vmcnt(0)" ::: "memory");
        } else {
            XB_SPIN(xb_ld(&bar[XB_XGEN(b.x)]) == gen, bar);
            __builtin_amdgcn_fence(__ATOMIC_ACQUIRE, "agent");
            asm volatile("s_waitcnt vmcnt(0)" ::: "memory");
        }
    }
    __syncthreads();
}

#define GB_CNT(g)   (3456 + 64 * (g))
#define GB_MASK(g)  (4096 + 64 * (g))
#define BAR_ZERO_WORDS 4608
__device__ __forceinline__ void group_barrier(unsigned* bar, unsigned g, unsigned nmem) {
    asm volatile("s_waitcnt vmcnt(0)" ::: "memory");
    __syncthreads();
    if (threadIdx.x == 0) {
        __builtin_amdgcn_s_waitcnt(0);
        const unsigned old = xb_add(&bar[GB_CNT(g)], 1u);
        const unsigned target = (old / nmem + 1u) * nmem;
        XB_SPIN(xb_ld(&bar[GB_CNT(g)]) < target, bar);
        __builtin_amdgcn_fence(__ATOMIC_ACQUIRE, "agent");
        asm volatile("s_waitcnt vmcnt(0)" ::: "memory");
    }
    __syncthreads();
}

struct Args { const float* in[15]; float* out; unsigned char* ws; };

#ifndef PROBE_A2
#define PROBE_A2 0
#endif
#ifndef PROBE_B2
#define PROBE_B2 0
#endif
#ifndef PROBE_P2
#define PROBE_P2 0
#endif
#ifndef PROBE_GU2
#define PROBE_GU2 0
#endif
#ifndef PROBE_RS2
#define PROBE_RS2 0
#endif
#ifndef PROBE_PJ2
#define PROBE_PJ2 0
#endif
#ifndef PROBE_S2
#define PROBE_S2 0
#endif
constexpr int NTHREADS = 512;
constexpr int LDS_BYTES = 151552;
constexpr int RSTD_OFF = 131072 + 1024;
constexpr int MISC_OFF = 131072 + 320;

__global__ void __launch_bounds__(NTHREADS, 2) yoco_fwd(Args args) {
    extern __shared__ __attribute__((aligned(16))) unsigned char lds_raw[];
    LAS unsigned char* lds = (LAS unsigned char*)lds_raw;
    cg::grid_group grid = cg::this_grid();
    const int tid = threadIdx.x, lane = tid & 63, wave = __builtin_amdgcn_readfirstlane(tid >> 6);
    constexpr int G = 256; const int bx = blockIdx.x;
    unsigned char* ws = args.ws;
    const float* x = args.in[0]; const float* ffn_norm = args.in[1]; const float* w_gate = args.in[2]; const float* w_up = args.in[3]; const float* w_down = args.in[4];
    const float* mix_norm = args.in[5]; const float* a_w_qkv = args.in[6]; const float* a_w_o = args.in[7]; const float* a_rel_bias = args.in[8];
    const float* kv_norm = args.in[9]; const float* b_w_kvf = args.in[10]; const float* b_f_bias = args.in[11]; const float* b_w_q = args.in[12]; const float* b_w_o = args.in[13];
    const float* final_norm = args.in[14];
    float* hout = args.out;

    unsigned* barw = (unsigned*)(ws + WS_BAR);
    volatile LAS unsigned* MISC = (volatile LAS unsigned*)(lds + MISC_OFF);
    if (tid < 2) MISC[tid] = 0u;
    if (bx == 0) for (int i = tid; i < BAR_ZERO_WORDS; i += NTHREADS) __hip_atomic_store(barw + i, 0u, __ATOMIC_RELAXED, __HIP_MEMORY_SCOPE_AGENT);
    {
        LAS float* scr = (LAS float*)(lds + wave * 16384);
        float* ssq = (float*)(ws + WS_SSQ); bf16_t* hb = (bf16_t*)(ws + WS_HB);
        const int gw = bx * 8 + wave, NGW = G * 8;
        constexpr int I_G = (DM / 64) * (FF / 32), I_D = (FF / 64) * (DM / 32), I_FFN = 2 * I_G + I_D;
        constexpr int I_QKV = (DM / 64) * (3 * DM / 32), I_SQ = (DM / 64) * (DM / 32), I_KVF = (DM / 64) * 65;
        constexpr int NITEMS = 8 * I_FFN + 2 * I_QKV + 2 * I_SQ + I_KVF + 2 * I_SQ + 2 * I_SQ;
        for (int rep = 0; rep < 1 + PROBE_P2; ++rep)
        for (int it = gw; it < NITEMS; it += NGW) {
            int r = it;
            if (r < 8 * I_FFN) {
                const int idx = r / I_FFN; r -= idx * I_FFN; bf16_t* wgu = (bf16_t*)(ws + WS_W + idx * W_FFN_BLK); bf16_t* wd = (bf16_t*)(ws + WS_W + idx * W_FFN_BLK + W_GU_BYTES);
                if (r < 2 * I_G) { const int s = r / I_G; r -= s * I_G; const int nblk = FF / 32, kb = r / nblk, nb = r % nblk, n0 = nb * 32;
                    cvt_item((s ? w_up : w_gate) + (size_t)idx * DM * FF, DM, FF, ffn_norm + idx * DM, wgu, 256 * (n0 >> 7) + 128 * s + (n0 & 127), kb * 64, n0, scr, lane, true); }
                else { r -= 2 * I_G; const int nblk = DM / 32, kb = r / nblk, nb = r % nblk; cvt_item(w_down + (size_t)idx * FF * DM, FF, DM, nullptr, wd, nb * 32, kb * 64, nb * 32, scr, lane, false); }
                continue;
            }
            r -= 8 * I_FFN;
            if (r < 2 * I_QKV) { const int la = r / I_QKV; r -= la * I_QKV; const int nblk = 3 * DM / 32, kb = r / nblk, nb = r % nblk;
                cvt_item(a_w_qkv + (size_t)la * DM * 3 * DM, DM, 3 * DM, mix_norm + la * DM, (bf16_t*)(ws + WS_WQKV) + (size_t)la * 3 * DM * DM, nb * 32, kb * 64, nb * 32, scr, lane, true); continue; }
            r -= 2 * I_QKV;
            if (r < 2 * I_SQ) { const int la = r / I_SQ; r -= la * I_SQ; const int nblk = DM / 32, kb = r / nblk, nb = r % nblk;
                cvt_item(a_w_o + (size_t)la * DM * DM, DM, DM, nullptr, (bf16_t*)(ws + WS_WAO) + (size_t)la * DM * DM, nb * 32, kb * 64, nb * 32, scr, lane, false); continue; }
            r -= 2 * I_SQ;
            if (r < I_KVF) { const int nblk = 65, kb = r / nblk, nb = r % nblk;
                cvt_item(b_w_kvf, DM, 2 * DM + NH, kv_norm, (bf16_t*)(ws + WS_WKVF), nb * 32, kb * 64, nb * 32, scr, lane, true); continue; }
            r -= I_KVF;
            if (r < 2 * I_SQ) { const int lb = r / I_SQ; r -= lb * I_SQ; const int nblk = DM / 32, kb = r / nblk, nb = r % nblk;
                cvt_item(b_w_q + (size_t)lb * DM * DM, DM, DM, mix_norm + (2 + lb) * DM, (bf16_t*)(ws + WS_WBQ) + (size_t)lb * DM * DM, nb * 32, kb * 64, nb * 32, scr, lane, true); continue; }
            r -= 2 * I_SQ;
            { const int lb = r / I_SQ; r -= lb * I_SQ; const int nblk = DM / 32, kb = r / nblk, nb = r % nblk;
                cvt_item(b_w_o + (size_t)lb * DM * DM, DM, DM, nullptr, (bf16_t*)(ws + WS_WBO) + (size_t)lb * DM * DM, nb * 32, kb * 64, nb * 32, scr, lane, false); }
        }
        for (int m = gw; m < TOK; m += NGW) {
            const f32x4* xr = (const f32x4*)(x + (size_t)m * DM) + lane; f32x4 v[4]; float s = 0.f;
#pragma unroll
            for (int j = 0; j < 4; ++j) v[j] = xr[64 * j];
            u32x2* o8 = (u32x2*)(hb + (size_t)m * DM) + lane;
#pragma unroll
            for (int j = 0; j < 4; ++j) { const u32x2 w = (u32x2){pack_h2(v[j].x, v[j].y), pack_h2(v[j].z, v[j].w)}; o8[64 * j] = w;
                const float r0 = h_lo(w.x), r1 = h_hi(w.x), r2 = h_lo(w.y), r3 = h_hi(w.y); s += (r0 * r0 + r1 * r1) + (r2 * r2 + r3 * r3); }
            s = wave_sum(s);
            if (lane < 16) ssq[(size_t)m * 16 + lane] = lane == 0 ? s : 0.f;
        }
    }
    __syncthreads();
    grid.sync();
    const XcdBarrier xb = xcd_barrier_post(barw, MISC);
    const int grp = bx & 7, gj = bx >> 3; constexpr int GJ = G >> 3;
    if (tid == 0) __hip_atomic_fetch_or(barw + GB_MASK(grp), 1u << xb.x, __ATOMIC_RELAXED, __HIP_MEMORY_SCOPE_AGENT);
    bool use_group = false;

#pragma unroll 1
    for (int opi = 0; opi < 58; ++opi) {
        const int op = opi >> 1, rep = opi & 1;
        unsigned char* wsv = args.ws; asm volatile("" : "+s"(wsv));
        float* ssq = (float*)(wsv + WS_SSQ); float* flog = (float*)(wsv + WS_FLOG); float* cum = (float*)(wsv + WS_CUM);
        bf16_t* hb = (bf16_t*)(wsv + WS_HB);
        bf16_t* Rq = (bf16_t*)(wsv + WS_R + (size_t)(bx & 7) * (16 * MiB)); bf16_t* Rk = Rq + (size_t)SEQ * DM; bf16_t* Rv = Rk + (size_t)SEQ * DM;
        bf16_t* mid = (bf16_t*)(wsv + WS_R + (size_t)(bx & 7) * (2 * MiB));
        bf16_t* Ksh = (bf16_t*)(wsv + WS_KSH); bf16_t* Vsh = (bf16_t*)(wsv + WS_VSH);
        unsigned char* ws = wsv;
        int tidv = threadIdx.x; asm volatile("" : "+v"(tidv));
        int l, j;
        if (op < 14) { l = op / 7; j = op % 7; } else if (op == 14) { l = 2; j = 7; } else { l = 2 + (op - 15) / 7; j = (op - 15) % 7; }
        const bool dbl = (PROBE_GU2 && (j == 0 || j == 5)) || (PROBE_RS2 && (j == 1 || j == 6 || j == 4)) || (PROBE_PJ2 && (j == 2 || j == 7));
        if (rep == 0 && !dbl) continue;
        const int p = j >= 5 ? 1 : 0;
        const int idx = l * 2 + p;
        const LAS float* rstdL = (const LAS float*)(lds + RSTD_OFF);
        if ((j == 0 || j == 5 || j == 2 || j == 7) && op != 15) {
            const GAS float* sp = (const GAS float*)ssq + ((size_t)grp * SEQ + tidv * 8) * 16;
#pragma unroll
            for (int r = 0; r < 8; ++r) { const f32x4 a = *(const GAS f32x4*)(sp + r * 16), b2 = *(const GAS f32x4*)(sp + r * 16 + 4), c = *(const GAS f32x4*)(sp + r * 16 + 8), d = *(const GAS f32x4*)(sp + r * 16 + 12);
                const float ssum = ((a.x + a.y) + (a.z + a.w)) + ((b2.x + b2.y) + (b2.z + b2.w)) + ((c.x + c.y) + (c.z + c.w)) + ((d.x + d.y) + (d.z + d.w));
                ((LAS float*)(lds + RSTD_OFF))[tidv * 8 + r] = __builtin_amdgcn_rsqf(ssum * (1.0f / DM) + EPS); }
            __syncthreads();
        }
        if (j == 7) {
            const int ln = tidv & 63, wv = __builtin_amdgcn_readfirstlane(tidv >> 6), m16 = ln & 15, kg = ln >> 4;
            const int rowl = gj * 128 + wv * 16 + m16;
            const GAS bf16_t* ap = (const GAS bf16_t*)hb + ((size_t)grp * SEQ + rowl) * DM + 8 * kg;
            const GAS bf16_t* wp = (const GAS bf16_t*)(ws + WS_WKVF) + (size_t)(2 * DM + m16) * DM + 8 * kg;
            f32x4 fa = {0.f, 0.f, 0.f, 0.f};
#pragma unroll 8
            for (int st = 0; st < 32; ++st) {
                const bf16x8 av = *(const GAS bf16x8*)(ap + 32 * st), wv8 = *(const GAS bf16x8*)(wp + 32 * st);
                fa = __builtin_amdgcn_mfma_f32_16x16x32_f16(__builtin_bit_cast(f16x8, wv8), __builtin_bit_cast(f16x8, av), fa, 0, 0, 0);
            }
            const float rr = rstdL[rowl];
            const f32x4 bb = *(const GAS f32x4*)((const GAS float*)b_f_bias + 4 * kg); f32x4 fo;
#pragma unroll
            for (int e = 0; e < 4; ++e) { const float xx = fa[e] * rr + bb[e]; fo[e] = fminf(xx, 0.f) - 0.6931471805599453f * __builtin_amdgcn_logf(1.0f + __builtin_amdgcn_exp2f(-fabsf(xx) * LOG2E)); }
            *(GAS f32x4*)((GAS float*)flog + ((size_t)grp * SEQ + rowl) * 16 + 4 * kg) = fo;
        }
        if (j == 0 || j == 5) {
            pg8::Gemm g{hb, (const bf16_t*)(ws + WS_W + idx * W_FFN_BLK), TOK, 2 * FF, DM}; pg8::StaticOrder S; S.init(TOK, 2 * FF, G, bx);
            pg8::EpiSwiglu E{mid, rstdL, grp * SEQ};
            pg8::gemm_phase<pg8::EpiSwiglu, pg8::StaticOrder, true, true>(lds, g, S, E, tidv);
        } else if (j == 1 || j == 6 || j == 4) {
            if (op == 16 && gj < NH) {
                const int b = grp, hh = gj; const float* src = flog + ((size_t)b * SEQ + tid * 8) * 16 + hh; float v[8];
#pragma unroll
                for (int i = 0; i < 8; ++i) v[i] = src[(size_t)i * 16];
#pragma unroll
                for (int i = 1; i < 8; ++i) v[i] += v[i - 1];
                float incl = v[7];
#pragma unroll
                for (int o = 1; o < 64; o <<= 1) { const float t2 = __shfl_up(incl, o); if (lane >= o) incl += t2; }
                volatile LAS float* wtot = (volatile LAS float*)(lds + MISC_OFF + 64);
                if (lane == 63) wtot[wave] = incl;
                __syncthreads();
                float base = incl - v[7];
                for (int w = 0; w < wave; ++w) base += wtot[w];
                float* dst = cum + ((size_t)b * NH + hh) * SEQ + tid * 8;
                *(f32x4*)dst = (f32x4){base + v[0], base + v[1], base + v[2], base + v[3]}; *(f32x4*)(dst + 4) = (f32x4){base + v[4], base + v[5], base + v[6], base + v[7]};
            }
            const bool isO = (j == 4);
            const bf16_t* A = isO ? Rq : mid;
            const bf16_t* Bt = isO ? (l < 2 ? (const bf16_t*)(ws + WS_WAO) + (size_t)l * DM * DM : (const bf16_t*)(ws + WS_WBO) + (size_t)(l - 2) * DM * DM)
                                   : (const bf16_t*)(ws + WS_W + idx * W_FFN_BLK + W_GU_BYTES);
            pg8::Gemm g{A, Bt, TOK, DM, isO ? DM : FF}; pg8::StaticOrder S; S.init(TOK, DM, G, bx);
            pg8::EpiResid E{hb, ssq, (dbl && rep == 0) ? 0.0f : (isO ? 1.0f : 0.5f)};
            pg8::gemm_phase<pg8::EpiResid, pg8::StaticOrder, true, true>(lds, g, S, E, tidv);
        } else if (j == 2 || j == 7) {
            const bf16_t* Bt; int N; bf16_t* O0; long ostr; float sc; float* fl = nullptr;
            if (j == 7) { Bt = (const bf16_t*)(ws + WS_WKVF); N = 2 * DM; O0 = Ksh; ostr = (long)((WS_VSH - WS_KSH) / 2); sc = 1.0f; }
            else if (l < 2) { Bt = (const bf16_t*)(ws + WS_WQKV) + (size_t)l * 3 * DM * DM; N = 3 * DM; O0 = Rq; ostr = (long)SEQ * DM; sc = QSCALE; }
            else { Bt = (const bf16_t*)(ws + WS_WBQ) + (size_t)(l - 2) * DM * DM; N = DM; O0 = Rq; ostr = 0; sc = QSCALE; }
            pg8::Gemm g{hb, Bt, TOK, N, DM}; pg8::StaticOrder S; S.init(TOK, N, G, bx);
            pg8::EpiProj E{O0, ostr, rstdL, grp * SEQ, sc, fl, b_f_bias};
            pg8::gemm_phase<pg8::EpiProj, pg8::StaticOrder, true, true>(lds, g, S, E, tidv);
        } else {
            if (l < 2) {
                for (int v = gj; v < NH * 16; v += GJ) { const int hh = v & 15, qb = v >> 4;
                    if (PROBE_A2) att::attn_unit<0>(lds, Rq, Rk, Rv, Vsh, a_rel_bias + (size_t)l * NH * NREL, grp, hh, qb, tidv);
                    att::attn_unit<0>(lds, Rq, Rk, Rv, Rq, a_rel_bias + (size_t)l * NH * NREL, grp, hh, qb, tidv); }
            } else {
                for (int i = 0; i < 8; ++i) { const int hh = 4 * (gj >> 3) + (i >> 1), sidx = gj & 7, qb = (i & 1) ? 15 - sidx : sidx;
                    if (PROBE_B2) att::attn_unit<1>(lds, Rq, Ksh, Vsh, Rk, cum, grp, hh, qb, tidv);
                    att::attn_unit<1>(lds, Rq, Ksh, Vsh, Rq, cum, grp, hh, qb, tidv); }
            }
        }
        if (op != 14) {
            if (use_group && op != 13) group_barrier(barw, (unsigned)grp, (unsigned)GJ);
            else { xcd_barrier(xb);
                if (op == 0) {
                    bool ok = true;
#pragma unroll
                    for (int g = 0; g < 8; ++g) { const unsigned mk = xb_ld(barw + GB_MASK(g)); ok = ok && (mk != 0u) && ((mk & (mk - 1u)) == 0u); }
                    use_group = ok && !PROBE_S2; } }
        }
    }

    {
        const bf16_t* hb = (const bf16_t*)(ws + WS_HB);
        for (int r = gj * 8 + wave; r < SEQ; r += GJ * 8) { const int m = grp * SEQ + r;
            const u32x2* hr = (const u32x2*)(hb + (size_t)m * DM) + lane; f32x4* xr = (f32x4*)(hout + (size_t)m * DM) + lane; const f32x4* gr = (const f32x4*)final_norm + lane; f32x4 v[4]; float s = 0.f;
#pragma unroll
            for (int jj = 0; jj < 4; ++jj) { const u32x2 w = hr[64 * jj]; v[jj] = (f32x4){h_lo(w.x), h_hi(w.x), h_lo(w.y), h_hi(w.y)}; s += (v[jj].x * v[jj].x + v[jj].y * v[jj].y) + (v[jj].z * v[jj].z + v[jj].w * v[jj].w); }
            const float rs = rsqrtf(wave_sum(s) * (1.0f / DM) + EPS);
#pragma unroll
            for (int jj = 0; jj < 4; ++jj) __builtin_nontemporal_store(v[jj] * rs * gr[64 * jj], xr + 64 * jj);
        }
    }
}

extern "C" void kernel_launch(void* const* d_in, const int* in_sizes, int n_in, void* d_out, int out_size, void* d_ws, size_t ws_size, hipStream_t stream) {
    static int grid = 0;
    if (grid == 0) {
        if (n_in != 15 || out_size != TOK * DM || ws_size < WS_END) { fprintf(stderr, "kernel_launch: unexpected shapes (n_in %d out %d ws %zu)\n", n_in, out_size, ws_size); grid = -1; return; }
        int dev = 0, cus = 0, per_cu = 0;
        hipGetDevice(&dev); hipDeviceGetAttribute(&cus, hipDeviceAttributeMultiprocessorCount, dev);
        if (hipFuncSetAttribute((const void*)yoco_fwd, hipFuncAttributeMaxDynamicSharedMemorySize, LDS_BYTES) != hipSuccess) { fprintf(stderr, "kernel_launch: hipFuncSetAttribute failed\n"); grid = -1; return; }
        if (hipOccupancyMaxActiveBlocksPerMultiprocessor(&per_cu, (const void*)yoco_fwd, NTHREADS, LDS_BYTES) != hipSuccess || per_cu < 1) { fprintf(stderr, "kernel_launch: occupancy query says %d\n", per_cu); per_cu = 1; }
        (void)hipGetLastError();
        if (cus < 256) fprintf(stderr, "kernel_launch: this kernel needs 256 CUs (device reports %d)\n", cus);
        grid = 256;
    }
    if (grid < 0) return;
    Args a{};
    for (int i = 0; i < 15; ++i) a.in[i] = (const float*)d_in[i];
    a.out = (float*)d_out; a.ws = (unsigned char*)d_ws;
    void* kargs[] = {&a};
    hipError_t e = hipLaunchCooperativeKernel((const void*)yoco_fwd, dim3(grid), dim3(NTHREADS), kargs, LDS_BYTES, stream);
    if (e != hipSuccess) fprintf(stderr, "cooperative launch failed: %s (grid %d)\n", hipGetErrorString(e), grid);
}
```

```cpp
#include <hip/hip_runtime.h>
#include <hip/hip_cooperative_groups.h>
#include <cstdio>
#include <cstdint>
namespace cg = cooperative_groups;

#define LAS __attribute__((address_space(3)))
typedef unsigned short bf16_t;
typedef short bf16x8 __attribute__((ext_vector_type(8)));
typedef short s16x4 __attribute__((ext_vector_type(4)));
typedef float f32x4 __attribute__((ext_vector_type(4)));
typedef float f32x16 __attribute__((ext_vector_type(16)));
typedef unsigned u32x4 __attribute__((ext_vector_type(4)));
typedef unsigned u32x2 __attribute__((ext_vector_type(2)));
typedef _Float16 f16x8 __attribute__((ext_vector_type(8)));
typedef _Float16 f16x2 __attribute__((ext_vector_type(2)));
__device__ __forceinline__ unsigned pack_h2(float a, float b) { const f16x2 v = {(_Float16)a, (_Float16)b}; return __builtin_bit_cast(unsigned, v); }
__device__ __forceinline__ float h_lo(unsigned w) { return (float)__builtin_bit_cast(f16x2, w).x; }
__device__ __forceinline__ float h_hi(unsigned w) { return (float)__builtin_bit_cast(f16x2, w).y; }

constexpr int BATCH = 8, SEQ = 4096, DM = 1024, NH = 16, HD = 64, FF = 2816, TOK = BATCH * SEQ, NREL = 513;
constexpr float EPS = 1e-6f;
constexpr float LOG2E = 1.4426950408889634f;
constexpr float QSCALE = 0.125f * LOG2E;

constexpr size_t MiB = 1u << 20;
constexpr size_t WS_SSQ = 0;
constexpr size_t WS_FLOG = 2 * MiB;
constexpr size_t WS_CUM = 4 * MiB;
constexpr size_t WS_BAR = 6 * MiB;
constexpr size_t WS_W = 8 * MiB;
constexpr size_t W_FFN_BLK = (size_t)(2 * FF * DM + DM * FF) * 2;
constexpr size_t W_GU_BYTES = (size_t)2 * FF * DM * 2;
constexpr size_t WS_WQKV = WS_W + 8 * W_FFN_BLK;
constexpr size_t WS_WAO = WS_WQKV + 2 * (size_t)3 * DM * DM * 2;
constexpr size_t WS_WKVF = WS_WAO + 2 * (size_t)DM * DM * 2;
constexpr size_t WS_WBQ = WS_WKVF + (size_t)2304 * DM * 2;
constexpr size_t WS_WBO = WS_WBQ + 2 * (size_t)DM * DM * 2;
constexpr size_t WS_WEND = WS_WBO + 2 * (size_t)DM * DM * 2;
constexpr size_t WS_HB = 169 * MiB;
constexpr size_t WS_R = 233 * MiB;
constexpr size_t WS_VSH = 425 * MiB;
constexpr size_t WS_KSH = WS_W;
constexpr size_t WS_END = 489 * MiB;
static_assert(WS_WEND <= WS_HB, "weights overflow");
static_assert(4 * W_FFN_BLK >= (size_t)TOK * DM * 2, "K_sh overlay must fit in the layer 0/1 FFN weights");
static_assert((size_t)SEQ * FF * 2 <= 24 * MiB && 3 * (size_t)SEQ * DM * 2 <= 24 * MiB && 8 * 24 * MiB <= WS_VSH - WS_R, "per-batch regions fit R");

namespace pg8 {
constexpr int BM = 256, BK = 64, HALF = 128, HTB = HALF * BK * 2, STAGE_BYTES = 8 * HTB, NXCD = 8, WGM = 4;
__host__ __device__ __forceinline__ int lds_byte(int r, int c) { const int st = (r >> 4) * 2 + (c >> 5), rr = r & 15, cc = c & 31, ob = rr * 64 + cc * 2; return st * 1024 + (ob ^ (((ob >> 9) & 1) << 5)); }
__host__ __device__ __forceinline__ void stage_rc(int b, int& R, int& C) { const int st = b / 1024, sb = b % 1024, swz = sb ^ (((sb >> 9) & 1) << 5); R = (st >> 1) * 16 + swz / 64; C = (st & 1) * 32 + (swz % 64) / 2; }
__host__ __device__ __forceinline__ int perm32(int rho) { const int n = rho >> 4, i = rho & 15; return 8 * (i >> 2) + 4 * n + (i & 3); }

struct Unit { int pm, pn; };
struct Gemm { const bf16_t* A; const bf16_t* Bt; int M, N, K; };

struct StaticOrder {
    int nM, nN, nwg, G, c;
    __host__ __device__ void init(int M, int N, int G_, int c_) { nM = M / BM; nN = N / BM; nwg = nM * nN; G = G_; c = c_; }
    __host__ __device__ bool next(int i, Unit& u) const {
        const long L = (long)i * G + c; if (L >= nwg) return false;
        int wgid = (int)L; { const int q = nwg / NXCD, r = nwg % NXCD, xcd = wgid % NXCD, off = wgid / NXCD; wgid = (xcd < r ? xcd * (q + 1) : r * (q + 1) + (xcd - r) * q) + off; }
        const int nig = WGM * nN, gid = wgid / nig, fm = gid * WGM, gsz = (nM - fm) < WGM ? (nM - fm) : WGM;
        u.pm = fm + ((wgid % nig) % gsz); u.pn = (wgid % nig) / gsz; return true;
    }
    __device__ __forceinline__ void a_ready(const Unit&) const {}
    __device__ __forceinline__ void done(const Unit&) const {}
};

__device__ __forceinline__ unsigned cvt_pk_bf16(float lo, float hi) { unsigned r; asm volatile("v_cvt_pk_bf16_f32 %0, %1, %2" : "=v"(r) : "v"(lo), "v"(hi)); return r; }

__device__ __forceinline__ float fq_sum(float v) {
    auto a = __builtin_amdgcn_permlane16_swap(__float_as_uint(v), __float_as_uint(v), false, false); v = __uint_as_float(a[0]) + __uint_as_float(a[1]);
    auto b = __builtin_amdgcn_permlane32_swap(__float_as_uint(v), __float_as_uint(v), false, false); return __uint_as_float(b[0]) + __uint_as_float(b[1]);
}
#define GAS __attribute__((address_space(1)))
__device__ __forceinline__ float fmul_s(float a, float b) { float r; asm("v_mul_f32_e32 %0, %1, %2" : "=v"(r) : "v"(a), "v"(b)); return r; }
__device__ __forceinline__ float row_rstd(const GAS float* ssq, int row, int fq) {
    const f32x4 pp = *(const GAS f32x4*)(ssq + (size_t)row * 16 + 4 * fq);
    const float s = fq_sum((pp.x + pp.y) + (pp.z + pp.w));
    return __builtin_amdgcn_rsqf(s * (1.0f / DM) + EPS);
}

struct EpiSwiglu {
    static constexpr bool PERM = true, AFTER_DRAIN = false, F16 = true;
    bf16_t* O; const LAS float* rstd; int rowbase;
    __device__ __forceinline__ void operator()(const f32x4 (&acc)[2][2][4][2], const Unit& u, int wr, int wc, int fr, int fq) const {
        const int row0 = u.pm * BM + wr * 64 + fr, col0 = u.pn * HALF + wc * 32 + 8 * fq;
        GAS bf16_t* O_g = (GAS bf16_t*)O;
        float rs[8];
#pragma unroll
        for (int i = 0; i < 8; ++i) rs[i] = rstd[row0 + (i >> 2) * HALF + (i & 3) * 16 - rowbase];
#pragma unroll
        for (int ai = 0; ai < 2; ++ai)
#pragma unroll
            for (int m = 0; m < 4; ++m) {
                const int row = row0 + ai * HALF + m * 16; const float r = rs[ai * 4 + m], nrl = -r * LOG2E, rs2 = r * r;
                unsigned w[4];
#pragma unroll
                for (int n = 0; n < 2; ++n) {
                    const f32x4 g = acc[ai][0][m][n], up = acc[ai][1][m][n];
                    const f32x4 t = g * nrl; f32x4 ex, sg;
#pragma unroll
                    for (int e = 0; e < 4; ++e) ex[e] = __builtin_amdgcn_exp2f(t[e]);
                    const f32x4 d = ex + 1.0f;
#pragma unroll
                    for (int e = 0; e < 4; ++e) sg[e] = __builtin_amdgcn_rcpf(d[e]);
                    const f32x4 y = (g * up) * (sg * rs2);
                    w[2 * n] = cvt_pk_bf16(y[0], y[1]); w[2 * n + 1] = cvt_pk_bf16(y[2], y[3]);
                }
                *(GAS u32x4*)(O_g + (size_t)row * FF + col0) = (u32x4){w[0], w[1], w[2], w[3]};
            }
    }
};

__device__ __forceinline__ float bf_lo(unsigned w) { return __uint_as_float(w << 16); }
__device__ __forceinline__ float bf_hi(unsigned w) { return __uint_as_float(w & 0xffff0000u); }
struct EpiResid {
    static constexpr bool PERM = true, AFTER_DRAIN = false, F16 = false;
    bf16_t* hb; float* ssq; float alpha;
    __device__ __forceinline__ void operator()(const f32x4 (&acc)[2][2][4][2], const Unit& u, int wr, int wc, int fr, int fq) const {
        const int row0 = u.pm * BM + wr * 64 + fr, col0 = u.pn * BM + wc * 32 + 8 * fq;
        GAS bf16_t* hb_g = (GAS bf16_t*)hb; GAS float* ssq_g = (GAS float*)ssq;
        u32x4 bv[8][2];
#pragma unroll
        for (int q = 0; q < 4; ++q)
#pragma unroll
            for (int bj = 0; bj < 2; ++bj) bv[q][bj] = *(const GAS u32x4*)(hb_g + (size_t)(row0 + (q >> 2) * HALF + (q & 3) * 16) * DM + col0 + bj * HALF);
#pragma unroll
        for (int q = 0; q < 8; ++q) {
            const int ai = q >> 2, m = q & 3;
            const int row = row0 + ai * HALF + m * 16; float ss = 0.f;
#pragma unroll
            for (int bj = 0; bj < 2; ++bj) {
                const size_t off = (size_t)row * DM + col0 + bj * HALF;
                const u32x4 b = bv[q][bj];
                const f32x4 a0 = acc[ai][bj][m][0] * alpha, a1 = acc[ai][bj][m][1] * alpha;
                u32x4 o;
                o.x = pack_h2(h_lo(b.x) + a0[0], h_hi(b.x) + a0[1]); o.y = pack_h2(h_lo(b.y) + a0[2], h_hi(b.y) + a0[3]);
                o.z = pack_h2(h_lo(b.z) + a1[0], h_hi(b.z) + a1[1]); o.w = pack_h2(h_lo(b.w) + a1[2], h_hi(b.w) + a1[3]);
                *(GAS u32x4*)(hb_g + off) = o;
                const float r0 = h_lo(o.x), r1 = h_hi(o.x), r2 = h_lo(o.y), r3 = h_hi(o.y), r4 = h_lo(o.z), r5 = h_hi(o.z), r6 = h_lo(o.w), r7 = h_hi(o.w);
                ss += (r0 * r0 + r1 * r1) + (r2 * r2 + r3 * r3) + (r4 * r4 + r5 * r5) + (r6 * r6 + r7 * r7);
            }
            if (q + 4 < 8) {
#pragma unroll
                for (int bj = 0; bj < 2; ++bj) bv[q + 4][bj] = *(const GAS u32x4*)(hb_g + (size_t)(row0 + ((q + 4) >> 2) * HALF + ((q + 4) & 3) * 16) * DM + col0 + bj * HALF);
            }
            ss = fq_sum(ss);
            if (fq == 0) ssq_g[(size_t)row * 16 + u.pn * 4 + wc] = ss;
        }
    }
};

struct EpiProj {
    static constexpr bool PERM = true, AFTER_DRAIN = false, F16 = true;
    bf16_t* O0; long ostride; const LAS float* rstd; int rowbase; float scale0; float* flog; const float* bf;
    __device__ __forceinline__ void operator()(const f32x4 (&acc)[2][2][4][2], const Unit& u, int wr, int wc, int fr, int fq) const {
        const int row0 = u.pm * BM + wr * 64 + fr; const int t = u.pn >> 2, pnl = u.pn & 3;
        float rs[8];
#pragma unroll
        for (int i = 0; i < 8; ++i) rs[i] = rstd[row0 + (i >> 2) * HALF + (i & 3) * 16 - rowbase];
        if (t == 2 && flog) {
            GAS float* flog_g = (GAS float*)flog; const GAS float* bf_g = (const GAS float*)bf;
            if (wc == 0 && fq < 2) {
                const f32x4 b0 = *(const GAS f32x4*)(bf_g + 8 * fq), b1 = *(const GAS f32x4*)(bf_g + 8 * fq + 4);
#pragma unroll
                for (int ai = 0; ai < 2; ++ai)
#pragma unroll
                    for (int m = 0; m < 4; ++m) {
                        const int row = row0 + ai * HALF + m * 16; const float r = rs[ai * 4 + m]; f32x4 o[2];
#pragma unroll
                        for (int n = 0; n < 2; ++n)
#pragma unroll
                            for (int e = 0; e < 4; ++e) { const float x = acc[ai][0][m][n][e] * r + (n == 0 ? b0[e] : b1[e]);
                                o[n][e] = fminf(x, 0.f) - 0.6931471805599453f * __builtin_amdgcn_logf(1.0f + __builtin_amdgcn_exp2f(-fabsf(x) * LOG2E)); }
                        *(GAS f32x4*)(flog_g + (size_t)row * 16 + 8 * fq) = o[0]; *(GAS f32x4*)(flog_g + (size_t)row * 16 + 8 * fq + 4) = o[1];
                    }
            }
            return;
        }
        GAS bf16_t* O = (GAS bf16_t*)O0 + (long)t * ostride; const float sc = t == 0 ? scale0 : 1.0f;
        const int col0 = pnl * BM + wc * 32 + 8 * fq;
#pragma unroll
        for (int ai = 0; ai < 2; ++ai)
#pragma unroll
            for (int m = 0; m < 4; ++m) {
                const int row = row0 + ai * HALF + m * 16; const float r = rs[ai * 4 + m] * sc;
#pragma unroll
                for (int bj = 0; bj < 2; ++bj) {
                    const f32x4 v0 = acc[ai][bj][m][0] * r, v1 = acc[ai][bj][m][1] * r;
                    *(GAS u32x4*)(O + (size_t)row * DM + col0 + bj * HALF) = (u32x4){cvt_pk_bf16(v0[0], v0[1]), cvt_pk_bf16(v0[2], v0[3]), cvt_pk_bf16(v1[0], v1[1]), cvt_pk_bf16(v1[2], v1[3])};
                }
            }
    }
};

typedef double f64x2_t __attribute__((ext_vector_type(2)));
__device__ __forceinline__ f32x4 zero4() {
    double a, b; asm volatile("v_mov_b64 %0, 0" : "=v"(a)); asm volatile("v_mov_b64 %0, 0" : "=v"(b));
    return __builtin_bit_cast(f32x4, (f64x2_t){a, b});
}
template <class Epi, class Sched, bool ALIGN_EPI = false, bool SP2 = false>
__device__ __forceinline__ void gemm_phase(LAS unsigned char* lds, const Gemm g, const Sched& S, const Epi& E, const int tid) {
    const int wid = __builtin_amdgcn_readfirstlane(tid >> 6), lane = tid & 63, wr = wid >> 2, wc = wid & 3, fr = lane & 15, fq = lane >> 4;
    const int K = g.K, nt = K / BK;
    unsigned voffA[2], voffB[2];
#pragma unroll
    for (int i = 0; i < 2; ++i) { int R, C; stage_rc(tid * 16 + i * 8192, R, C); const int Rb = Epi::PERM ? ((R & ~31) + perm32(R & 31)) : R;
        voffA[i] = (unsigned)(R * K + C) * 2u; voffB[i] = (unsigned)(Rb * K + C) * 2u; }
    const size_t kstep = (size_t)(BK * 2);
    const size_t hstep = (size_t)HALF * K * 2;
    const size_t tstep = 2 * hstep;
    const unsigned ldsw = (unsigned)wid * 1024u;
    const int aoff = lds_byte(wr * 64 + fr, fq * 8), boff = lds_byte(wc * 32 + fr, fq * 8);
#define PG8_SA(b, h) (((b) * 2 + (h)) * HTB)
#define PG8_SB(b, h) ((4 + (b) * 2 + (h)) * HTB)
#define PG8_STAGE(bufoff, gbase, voff) do { _Pragma("unroll") for (int _i = 0; _i < 2; ++_i) \
        __builtin_amdgcn_global_load_lds((const unsigned*)((const char*)(gbase) + (voff)[_i]), (LAS unsigned*)(lds + (bufoff) + ldsw + _i * 8192), 16, 0, 0); } while (0)
#define PG8_LDA(dst, b, h) do { _Pragma("unroll") for (int m = 0; m < 4; ++m) _Pragma("unroll") for (int k = 0; k < 2; ++k) dst[m][k] = *(const LAS bf16x8*)(lds + PG8_SA(b, h) + aoff + m * 2048 + k * 1024); } while (0)
#define PG8_LDB(dst, b, h) do { _Pragma("unroll") for (int n = 0; n < 2; ++n) _Pragma("unroll") for (int k = 0; k < 2; ++k) dst[n][k] = *(const LAS bf16x8*)(lds + PG8_SB(b, h) + boff + n * 2048 + k * 1024); } while (0)
#define PG8_MMA(ai, bj, At, Bt) do { __builtin_amdgcn_s_setprio(1); _Pragma("unroll") for (int m = 0; m < 4; ++m) _Pragma("unroll") for (int n = 0; n < 2; ++n) _Pragma("unroll") for (int k = 0; k < 2; ++k) \
        { if constexpr (Epi::F16) acc[ai][bj][m][n] = __builtin_amdgcn_mfma_f32_16x16x32_f16(__builtin_bit_cast(f16x8, Bt[n][k]), __builtin_bit_cast(f16x8, At[m][k]), acc[ai][bj][m][n], 0, 0, 0); \
          else acc[ai][bj][m][n] = __builtin_amdgcn_mfma_f32_16x16x32_bf16(Bt[n][k], At[m][k], acc[ai][bj][m][n], 0, 0, 0); } __builtin_amdgcn_s_setprio(0); } while (0)
#define PG8_WAIT_V(n) asm volatile("s_waitcnt vmcnt(" #n ")" ::: "memory")
#define PG8_WAIT_L(n) asm volatile("s_waitcnt lgkmcnt(" #n ")" ::: "memory")
#define PG8_BAR __builtin_amdgcn_s_barrier()
#define PG8_SCHED __builtin_amdgcn_sched_barrier(0)
    Unit cur, nxt; int ui = 0;
    if (!S.next(0, cur)) return;
    f32x4 acc[2][2][4][2];
#pragma unroll
    for (int a = 0; a < 2; ++a)
#pragma unroll
        for (int b = 0; b < 2; ++b)
#pragma unroll
            for (int m = 0; m < 4; ++m)
#pragma unroll
                for (int n = 0; n < 2; ++n) acc[a][b][m][n] = zero4();
    bf16x8 At[4][2], B0[2][2], B1[2][2];
    const char* cA = (const char*)g.A + (size_t)cur.pm * tstep; const char* cB = (const char*)g.Bt + (size_t)cur.pn * tstep;
    S.a_ready(cur);
    if constexpr (SP2) {
        PG8_STAGE(PG8_SB(0, 0), cB, voffB); PG8_STAGE(PG8_SB(0, 1), cB + hstep, voffB); PG8_STAGE(PG8_SA(0, 0), cA, voffA); PG8_STAGE(PG8_SA(0, 1), cA + hstep, voffA);
        if (wr == 1) PG8_BAR;
        PG8_WAIT_V(2); PG8_BAR;
        PG8_STAGE(PG8_SB(1, 0), cB + kstep, voffB); PG8_STAGE(PG8_SA(1, 0), cA + kstep, voffA); PG8_STAGE(PG8_SB(1, 1), cB + hstep + kstep, voffB);
        PG8_WAIT_V(6); PG8_BAR;
    } else {
        PG8_STAGE(PG8_SB(0, 0), cB, voffB); PG8_STAGE(PG8_SA(0, 0), cA, voffA); PG8_STAGE(PG8_SB(0, 1), cB + hstep, voffB); PG8_STAGE(PG8_SA(0, 1), cA + hstep, voffA);
        if (wr == 1) PG8_BAR;
        PG8_WAIT_V(4); PG8_BAR;
        PG8_STAGE(PG8_SB(1, 0), cB + kstep, voffB); PG8_STAGE(PG8_SA(1, 0), cA + kstep, voffA); PG8_STAGE(PG8_SB(1, 1), cB + hstep + kstep, voffB);
        PG8_WAIT_V(6); PG8_BAR;
    }
    for (;;) {
        const bool has_next = S.next(ui + 1, nxt);
        const char* nA = has_next ? (const char*)g.A + (size_t)nxt.pm * tstep : cA; const char* nB = has_next ? (const char*)g.Bt + (size_t)nxt.pn * tstep : cB;
        for (int t = 0; t < nt; t += 2) {
            const bool last = (t == nt - 2);
            const char* a1 = cA + (size_t)(t + 1) * kstep;
            const char* a2 = last ? nA : cA + (size_t)(t + 2) * kstep; const char* b2 = last ? nB : cB + (size_t)(t + 2) * kstep;
            const char* a3 = a2 + kstep; const char* b3 = b2 + kstep;
            if (last && has_next) S.a_ready(nxt);
            if constexpr (SP2) {
            PG8_LDB(B0, 0, 0); PG8_LDB(B1, 0, 1); PG8_SCHED; PG8_LDA(At, 0, 0); PG8_STAGE(PG8_SA(1, 1), a1 + hstep, voffA);
            PG8_WAIT_V(8); PG8_WAIT_L(0); PG8_BAR; PG8_MMA(0, 0, At, B0); PG8_MMA(0, 1, At, B1); PG8_BAR; PG8_SCHED;
            PG8_LDA(At, 0, 1); PG8_STAGE(PG8_SB(0, 0), b2, voffB); PG8_STAGE(PG8_SB(0, 1), b2 + hstep, voffB); PG8_STAGE(PG8_SA(0, 0), a2, voffA);
            PG8_WAIT_V(8); PG8_WAIT_L(0); PG8_BAR; PG8_MMA(1, 0, At, B0); PG8_MMA(1, 1, At, B1); PG8_BAR; PG8_SCHED;
            PG8_LDB(B0, 1, 0); PG8_LDB(B1, 1, 1); PG8_SCHED; PG8_LDA(At, 1, 0); PG8_STAGE(PG8_SA(0, 1), a2 + hstep, voffA);
            PG8_WAIT_V(8); PG8_WAIT_L(0); PG8_BAR; PG8_MMA(0, 0, At, B0); PG8_MMA(0, 1, At, B1); PG8_BAR; PG8_SCHED;
            PG8_LDA(At, 1, 1); PG8_STAGE(PG8_SB(1, 0), b3, voffB); PG8_STAGE(PG8_SB(1, 1), b3 + hstep, voffB); PG8_STAGE(PG8_SA(1, 0), a3, voffA);
            PG8_WAIT_V(8); PG8_WAIT_L(0); PG8_BAR; PG8_MMA(1, 0, At, B0); PG8_MMA(1, 1, At, B1); PG8_BAR; PG8_SCHED;
            } else {
            PG8_LDB(B0, 0, 0); PG8_SCHED; PG8_LDA(At, 0, 0); PG8_STAGE(PG8_SA(1, 1), a1 + hstep, voffA);
            PG8_WAIT_L(8); PG8_BAR; PG8_WAIT_L(0); PG8_MMA(0, 0, At, B0); PG8_BAR; PG8_SCHED;
            PG8_LDB(B1, 0, 1); PG8_STAGE(PG8_SB(0, 0), b2, voffB);
            PG8_BAR; PG8_WAIT_L(0); PG8_MMA(0, 1, At, B1); PG8_BAR;
            PG8_LDA(At, 0, 1); PG8_STAGE(PG8_SA(0, 0), a2, voffA);
            PG8_BAR; PG8_WAIT_L(0); PG8_MMA(1, 0, At, B0); PG8_BAR; PG8_SCHED;
            PG8_STAGE(PG8_SB(0, 1), b2 + hstep, voffB);
            PG8_WAIT_V(6); PG8_BAR; PG8_MMA(1, 1, At, B1); PG8_BAR;
            PG8_LDB(B0, 1, 0); PG8_SCHED; PG8_LDA(At, 1, 0); PG8_STAGE(PG8_SA(0, 1), a2 + hstep, voffA);
            PG8_WAIT_L(8); PG8_BAR; PG8_WAIT_L(0); PG8_MMA(0, 0, At, B0); PG8_BAR; PG8_SCHED;
            PG8_LDB(B1, 1, 1); PG8_STAGE(PG8_SB(1, 0), b3, voffB);
            PG8_BAR; PG8_WAIT_L(0); PG8_MMA(0, 1, At, B1); PG8_BAR;
            PG8_LDA(At, 1, 1); PG8_STAGE(PG8_SA(1, 0), a3, voffA);
            PG8_BAR; PG8_WAIT_L(0); PG8_MMA(1, 0, At, B0); PG8_BAR; PG8_SCHED;
            PG8_STAGE(PG8_SB(1, 1), b3 + hstep, voffB);
            PG8_WAIT_V(6); PG8_BAR; PG8_MMA(1, 1, At, B1); PG8_BAR;
            }
        }
        if constexpr (ALIGN_EPI) { if (wr == 0) PG8_BAR; }
        if constexpr (!Epi::AFTER_DRAIN) { E(acc, cur, wr, wc, fr, fq); S.done(cur); }
        if (!has_next) break;
#pragma unroll
        for (int a = 0; a < 2; ++a)
#pragma unroll
            for (int b = 0; b < 2; ++b)
#pragma unroll
                for (int m = 0; m < 4; ++m)
#pragma unroll
                    for (int n = 0; n < 2; ++n) acc[a][b][m][n] = zero4();
        cur = nxt; cA = nA; cB = nB; ++ui;
        if constexpr (ALIGN_EPI) { if (wr == 1) PG8_BAR; }
    }
    PG8_WAIT_V(0);
    if constexpr (!ALIGN_EPI) { if (wr == 0) PG8_BAR; }
    PG8_BAR;
#undef PG8_SA
#undef PG8_SB
#undef PG8_STAGE
#undef PG8_LDA
#undef PG8_LDB
#undef PG8_MMA
#undef PG8_WAIT_V
#undef PG8_WAIT_L
#undef PG8_BAR
#undef PG8_SCHED
}
}

namespace att {
constexpr int L_K = 0, L_V = 40960, L_KB = 81920, L_BIAS = 83200, NTAB = 639, L_END = 83200 + 2560;
__device__ __forceinline__ int crow(int r, int hi) { return (r & 3) + 8 * (r >> 2) + 4 * hi; }
__device__ __forceinline__ unsigned cvtpk(float lo, float hi) { unsigned r; asm volatile("v_cvt_pk_bf16_f32 %0, %1, %2" : "=v"(r) : "v"(lo), "v"(hi)); return r; }
typedef float f32x2_t __attribute__((ext_vector_type(2))); typedef __bf16 bf16x2_t __attribute__((ext_vector_type(2)));
__device__ __forceinline__ unsigned cvtpk_c(float lo, float hi) { const f32x2_t v = {lo, hi}; const bf16x2_t b = __builtin_convertvector(v, bf16x2_t); return __builtin_bit_cast(unsigned, b); }
__device__ __forceinline__ s16x4 vtr(LAS const unsigned char* p) { return __builtin_bit_cast(s16x4, __builtin_amdgcn_ds_read_tr16_b64_v4i16((LAS s16x4*)p)); }

__device__ __forceinline__ float fadd_s(float a, float b) { float r; asm("v_add_f32_e32 %0, %1, %2" : "=v"(r) : "v"(a), "v"(b)); return r; }
__device__ __forceinline__ float fsub_s(float a, float b) { float r; asm("v_sub_f32_e32 %0, %1, %2" : "=v"(r) : "v"(a), "v"(b)); return r; }
__device__ __forceinline__ float fadd_tr(float a, float b) { float r; asm("s_nop 0\n\tv_add_f32_e32 %0, %1, %2" : "=v"(r) : "v"(a), "v"(b)); return r; }
__device__ __forceinline__ unsigned cvtpk_tr(float lo, float hi) { unsigned r; asm volatile("s_nop 0\n\tv_cvt_pk_bf16_f32 %0, %1, %2" : "=v"(r) : "v"(lo), "v"(hi)); return r; }
__device__ __forceinline__ float fadd4_tr(float acc, float a, float b, float c, float d) {
    asm("s_nop 0\n\tv_add_f32_e32 %0, %0, %1\n\tv_add_f32_e32 %0, %0, %2\n\tv_add_f32_e32 %0, %0, %3\n\tv_add_f32_e32 %0, %0, %4" : "+v"(acc) : "v"(a), "v"(b), "v"(c), "v"(d)); return acc; }
__device__ __forceinline__ void cvtpk2_tr(unsigned& r0, unsigned& r1, float a, float b, float c, float d) {
    asm volatile("s_nop 0\n\tv_cvt_pk_bf16_f32 %0, %2, %3\n\tv_cvt_pk_bf16_f32 %1, %4, %5" : "=&v"(r0), "=&v"(r1) : "v"(a), "v"(b), "v"(c), "v"(d)); }
__device__ __forceinline__ float xhalf_max(float v) { auto rr = __builtin_amdgcn_permlane32_swap(__float_as_uint(v), __float_as_uint(v), false, false); return fmaxf(__uint_as_float(rr[0]), __uint_as_float(rr[1])); }
__device__ __forceinline__ float xhalf_sum(float v) { auto rr = __builtin_amdgcn_permlane32_swap(__float_as_uint(v), __float_as_uint(v), false, false); return __uint_as_float(rr[0]) + __uint_as_float(rr[1]); }
__device__ __forceinline__ float ffma_s(float a, float b, float c) { float r; asm("v_fma_f32 %0, %1, %2, %3" : "=v"(r) : "v"(a), "v"(b), "v"(c)); return r; }
__device__ __forceinline__ void glds16(const void* gsrc, unsigned lds_dst) { unsigned keep;
    asm volatile("s_mov_b32 %0, m0\n\ts_mov_b32 m0, %2\n\ts_nop 0\n\tglobal_load_lds_dwordx4 %1, off\n\ts_mov_b32 m0, %0" : "=&s"(keep) : "v"(gsrc), "s"(lds_dst) : "memory"); }
__device__ __forceinline__ void glds4(const void* gsrc, unsigned lds_dst) { unsigned keep;
    asm volatile("s_mov_b32 %0, m0\n\ts_mov_b32 m0, %2\n\ts_nop 0\n\tglobal_load_lds_dword %1, off\n\ts_mov_b32 m0, %0" : "=&s"(keep) : "v"(gsrc), "s"(lds_dst) : "memory"); }
template <int MODE>
__device__ __forceinline__ void attn_unit(LAS unsigned char* lds, const bf16_t* Q, const bf16_t* K, const bf16_t* V, bf16_t* O, const float* aux, int b, int h, int qb, const int tid) {
    const int lane = tid & 63, wid = __builtin_amdgcn_readfirstlane(tid >> 6), r32 = lane & 31, hi = lane >> 5;
    const size_t rowbase = (size_t)b * SEQ; const int q0 = qb * 256;
    const int t_begin = MODE == 0 ? (4 * qb - 8 > 0 ? 4 * qb - 8 : 0) : 0, t_end = 4 * qb + 4, nt = t_end - t_begin;
    const int cq = 4 * qb + (wid >> 1);
    const int w_lo = MODE == 0 ? cq - 8 : 0, w_hi = cq;
    asm volatile("s_waitcnt vmcnt(0)" ::: "memory");
    const bf16_t* ksrc = K + (rowbase + lane) * DM + h * HD + wid * 8;
    const bf16_t* vsrc = V + (rowbase + 16 * (wid & 3) + (lane >> 2)) * DM + h * HD + (wid >> 2) * 32 + (lane & 3) * 8;
    const float* cum = aux + ((size_t)b * NH + h) * SEQ;
    LAS float* biasL = (LAS float*)(lds + L_BIAS);
    if (MODE == 0) { const float* tab = aux + (size_t)h * NREL; for (int i = tid; i < NTAB; i += 512) { int rel = i - 63; rel = rel < -256 ? -256 : (rel > 256 ? 256 : rel); biasL[i] = tab[rel + 256] * LOG2E; } }
    bf16x8 qr[4];
    { const bf16_t* Qw = Q + (rowbase + q0 + wid * 32 + r32) * DM + h * HD + hi * 8;
#pragma unroll
      for (int s = 0; s < 4; ++s) qr[s] = *(const bf16x8*)(Qw + s * 16); }
    float beta = 0.f;
    if (MODE == 1) beta = __builtin_bit_cast(float, __builtin_amdgcn_readfirstlane(__builtin_bit_cast(int, cum[q0 + 32 * wid + 31] * (-LOG2E))));
    const unsigned lds0 = (unsigned)(uintptr_t)lds;
    const unsigned kdst = lds0 + L_K + wid * 1024, vdst = lds0 + L_V + wid * 1024, bdst = lds0 + L_KB;
    const bool w0 = (MODE == 1) && (wid == 0);
#define ATT_DMA(tt, slot) do { glds16(ksrc + (size_t)(tt) * 64 * DM, (unsigned)__builtin_amdgcn_readfirstlane(kdst + (slot) * 8192)); \
        glds16(vsrc + (size_t)(tt) * 64 * DM, (unsigned)__builtin_amdgcn_readfirstlane(vdst + (slot) * 8192)); \
        if (w0) glds4(cum + (tt) * 64 + lane, (unsigned)__builtin_amdgcn_readfirstlane(bdst + (slot) * 256)); } while (0)
#define ATT_WAITB(n) do { const int n_ = (n); \
        if (w0) { if (n_ >= 2) asm volatile("s_waitcnt vmcnt(6) lgkmcnt(0)\n\ts_barrier" ::: "memory"); else if (n_ == 1) asm volatile("s_waitcnt vmcnt(3) lgkmcnt(0)\n\ts_barrier" ::: "memory"); else asm volatile("s_waitcnt vmcnt(0) lgkmcnt(0)\n\ts_barrier" ::: "memory"); } \
        else    { if (n_ >= 2) asm volatile("s_waitcnt vmcnt(4) lgkmcnt(0)\n\ts_barrier" ::: "memory"); else if (n_ == 1) asm volatile("s_waitcnt vmcnt(2) lgkmcnt(0)\n\ts_barrier" ::: "memory"); else asm volatile("s_waitcnt vmcnt(0) lgkmcnt(0)\n\ts_barrier" ::: "memory"); } } while (0)
#pragma unroll
    for (int k = 0; k < 4; ++k) if (k < nt) ATT_DMA(t_begin + k, k);
    ATT_WAITB(nt - 2 > 2 ? 2 : (nt - 2 < 0 ? 0 : nt - 2));
    const unsigned kfoff = hi * 1024 + r32 * 16;
    bf16x8 kf[8];
#pragma unroll
    for (int s = 0; s < 4; ++s) { kf[2 * s] = *(LAS const bf16x8*)(lds + L_K + kfoff + s * 2048); kf[2 * s + 1] = *(LAS const bf16x8*)(lds + L_K + kfoff + s * 2048 + 512); }
    float mu = 0.f, lrun = 0.f; f32x16 o0 = {}, o1 = {};
    const int qpos = q0 + wid * 32 + r32;
    const int vlane = ((lane >> 4) & 1) * 32 + (lane & 3) * 8 + (4 * hi + ((lane & 15) >> 2)) * 64;
    constexpr float THR = 12.0f;
    int cur = 0;
    for (int i = 0; i < nt; ++i) {
        const int t = t_begin + i; const int nxt = cur == 4 ? 0 : cur + 1, s4 = cur == 0 ? 4 : cur - 1;
        if (i + 4 < nt) ATT_DMA(t + 4, s4);
        const bool act = (t >= w_lo && t <= w_hi);
        f32x16 p0, p1; s16x4 vf[16];
        if (act) {
            if (MODE == 0) {
                LAS const float* bp = biasL + (qpos - 64 * t - 4 * hi + 4);
#pragma unroll
                for (int r = 0; r < 16; ++r) { const int kvl = (r & 3) + 8 * (r >> 2); p0[r] = bp[59 - kvl]; p1[r] = bp[27 - kvl]; }
                if (__any(mu != 0.f)) {
#pragma unroll
                    for (int r = 0; r < 16; ++r) { p0[r] -= mu; p1[r] -= mu; } }
            } else {
                LAS const float* kb = (LAS const float*)(lds + L_KB + cur * 256) + 4 * hi; const float noff = -(beta + mu);
#pragma unroll
                for (int g = 0; g < 4; ++g) { const f32x4 a = *(LAS const f32x4*)(kb + 8 * g), c = *(LAS const f32x4*)(kb + 32 + 8 * g);
#pragma unroll
                    for (int e = 0; e < 4; ++e) { p0[4 * g + e] = ffma_s(a[e], -LOG2E, noff); p1[4 * g + e] = ffma_s(c[e], -LOG2E, noff); } }
            }
#pragma unroll
            for (int s = 0; s < 4; ++s) {
                p0 = __builtin_amdgcn_mfma_f32_32x32x16_bf16(kf[2 * s], qr[s], p0, 0, 0, 0);
                p1 = __builtin_amdgcn_mfma_f32_32x32x16_bf16(kf[2 * s + 1], qr[s], p1, 0, 0, 0);
            }
            LAS const unsigned char* vp = lds + L_V + cur * 8192 + vlane;
#pragma unroll
            for (int s = 0; s < 4; ++s) { vf[4 * s] = vtr(vp + s * 1024); vf[4 * s + 1] = vtr(vp + s * 1024 + 512); vf[4 * s + 2] = vtr(vp + 4096 + s * 1024); vf[4 * s + 3] = vtr(vp + 4096 + s * 1024 + 512); }
        }
        if (i + 1 < nt) {
#pragma unroll
            for (int s = 0; s < 4; ++s) { kf[2 * s] = *(LAS const bf16x8*)(lds + L_K + nxt * 8192 + kfoff + s * 2048); kf[2 * s + 1] = *(LAS const bf16x8*)(lds + L_K + nxt * 8192 + kfoff + s * 2048 + 512); }
        }
        if (act) {
            if (MODE == 1 && t == cq) {
                const int kp0 = 64 * t + 4 * hi;
#pragma unroll
                for (int r = 0; r < 16; ++r) { const int kvp = kp0 + (r & 3) + 8 * (r >> 2); if (kvp > qpos) p0[r] = -1e30f; if (kvp + 32 > qpos) p1[r] = -1e30f; }
            }
            float mt = __builtin_fmaxf(__builtin_fmaxf(p0[0], p1[0]), p0[1]);
#pragma unroll
            for (int r = 1; r < 16; ++r) { if (r > 1) mt = __builtin_fmaxf(__builtin_fmaxf(mt, p0[r]), p1[r]); else mt = __builtin_fmaxf(mt, p1[1]); }
            mt = xhalf_max(mt);
            if (__any(mt > THR)) {
                const float d = fmaxf(mt, 0.f), f = __builtin_amdgcn_exp2f(-d); mu += d; lrun *= f;
#pragma unroll
                for (int r = 0; r < 16; ++r) { p0[r] -= d; p1[r] -= d; o0[r] *= f; o1[r] *= f; }
            }
#pragma unroll
            for (int r = 0; r < 16; ++r) { p0[r] = __builtin_amdgcn_exp2f(p0[r]); p1[r] = __builtin_amdgcn_exp2f(p1[r]); }
            float ls0 = 0.f, ls1 = 0.f;
#pragma unroll
            for (int r = 0; r < 16; r += 4) { ls0 = fadd4_tr(ls0, p0[r], p0[r + 1], p0[r + 2], p0[r + 3]); ls1 = fadd4_tr(ls1, p1[r], p1[r + 1], p1[r + 2], p1[r + 3]); }
            lrun = fadd_s(lrun, fadd_s(ls0, ls1));
#pragma unroll
            for (int s = 0; s < 4; ++s) {
                u32x4 pw;
                unsigned w0_, w1_, w2_, w3_;
                if (s == 0) { cvtpk2_tr(w0_, w1_, p0[0], p0[1], p0[2], p0[3]); cvtpk2_tr(w2_, w3_, p0[4], p0[5], p0[6], p0[7]); }
                else if (s == 1) { cvtpk2_tr(w0_, w1_, p0[8], p0[9], p0[10], p0[11]); cvtpk2_tr(w2_, w3_, p0[12], p0[13], p0[14], p0[15]); }
                else if (s == 2) { cvtpk2_tr(w0_, w1_, p1[0], p1[1], p1[2], p1[3]); cvtpk2_tr(w2_, w3_, p1[4], p1[5], p1[6], p1[7]); }
                else { cvtpk2_tr(w0_, w1_, p1[8], p1[9], p1[10], p1[11]); cvtpk2_tr(w2_, w3_, p1[12], p1[13], p1[14], p1[15]); }
                pw = (u32x4){w0_, w1_, w2_, w3_};
                const bf16x8 pb = __builtin_bit_cast(bf16x8, pw);
                const s16x4 a0 = vf[4 * s], a1 = vf[4 * s + 1], c0 = vf[4 * s + 2], c1 = vf[4 * s + 3];
                const bf16x8 v0 = (bf16x8){a0[0], a0[1], a0[2], a0[3], a1[0], a1[1], a1[2], a1[3]};
                const bf16x8 v1 = (bf16x8){c0[0], c0[1], c0[2], c0[3], c1[0], c1[1], c1[2], c1[3]};
                o0 = __builtin_amdgcn_mfma_f32_32x32x16_bf16(v0, pb, o0, 0, 0, 0);
                o1 = __builtin_amdgcn_mfma_f32_32x32x16_bf16(v1, pb, o1, 0, 0, 0);
            }
        }
        { const int rem = nt - i - 3; ATT_WAITB(rem > 2 ? 2 : (rem < 0 ? 0 : rem)); }
        cur = nxt;
    }
#undef ATT_DMA
#undef ATT_WAITB
    const float ltot = fmaxf(xhalf_sum(lrun), 1e-37f); const float inv = __builtin_amdgcn_rcpf(ltot);
    unsigned ox[8], oy[8];
#pragma unroll
    for (int g = 0; g < 4; ++g) {
        ox[g] = cvtpk_c(o0[4 * g] * inv, o0[4 * g + 1] * inv); oy[g] = cvtpk_c(o0[4 * g + 2] * inv, o0[4 * g + 3] * inv);
        ox[4 + g] = cvtpk_c(o1[4 * g] * inv, o1[4 * g + 1] * inv); oy[4 + g] = cvtpk_c(o1[4 * g + 2] * inv, o1[4 * g + 3] * inv);
    }
    bf16_t* Ow = O + (rowbase + q0 + wid * 32 + r32) * DM + h * HD + 8 * hi;
#pragma unroll
    for (int k = 0; k < 8; k += 2) {
        const auto rx = __builtin_amdgcn_permlane32_swap(ox[k], ox[k + 1], false, false);
        const auto ry = __builtin_amdgcn_permlane32_swap(oy[k], oy[k + 1], false, false);
        *(u32x4*)(Ow + 8 * k) = (u32x4){rx[0], ry[0], rx[1], ry[1]};
    }
}
}

__device__ __forceinline__ float wave_sum(float v) {
#pragma unroll
    for (int o = 1; o < 64; o <<= 1) v += __shfl_xor(v, o);
    return v;
}
__device__ __forceinline__ void cvt_item(const float* W, int K, int N, const float* gain, bf16_t* WT, int drow0, int k0, int n0, LAS float* scr, int lane, bool f16) {
    const int n = n0 + (lane & 31); const bool ok = n < N;
    float v[32];
    { const float* src = W + (size_t)(k0 + (lane >> 5)) * N + n;
#pragma unroll
      for (int i = 0; i < 32; ++i) v[i] = ok ? src[(size_t)(2 * i) * N] : 0.f; }
#pragma unroll
    for (int i = 0; i < 32; ++i) scr[(2 * i + (lane >> 5)) * 33 + (lane & 31)] = v[i];
    f32x4 g0 = (f32x4){1.f, 1.f, 1.f, 1.f}, g1 = g0;
    if (gain) { g0 = *(const f32x4*)(gain + k0 + 8 * (lane & 7)); g1 = *(const f32x4*)(gain + k0 + 8 * (lane & 7) + 4); }
    asm volatile("s_waitcnt lgkmcnt(0)" ::: "memory");
    const int c = lane & 7;
#pragma unroll
    for (int j = 0; j < 4; ++j) { const int nn = (lane >> 3) + 8 * j; const LAS float* s = scr + (8 * c) * 33 + nn;
        u32x4 o;
        const float e0 = s[0 * 33] * g0.x, e1 = s[1 * 33] * g0.y, e2 = s[2 * 33] * g0.z, e3 = s[3 * 33] * g0.w, e4 = s[4 * 33] * g1.x, e5 = s[5 * 33] * g1.y, e6 = s[6 * 33] * g1.z, e7 = s[7 * 33] * g1.w;
        if (f16) { o.x = pack_h2(e0, e1); o.y = pack_h2(e2, e3); o.z = pack_h2(e4, e5); o.w = pack_h2(e6, e7); }
        else { o.x = pg8::cvt_pk_bf16(e0, e1); o.y = pg8::cvt_pk_bf16(e2, e3); o.z = pg8::cvt_pk_bf16(e4, e5); o.w = pg8::cvt_pk_bf16(e6, e7); }
        *(u32x4*)(WT + (size_t)(drow0 + nn) * K + k0 + 8 * c) = o; }
    asm volatile("s_waitcnt lgkmcnt(0)" ::: "memory");
}

#define XB_TMO      128
#define XB_XCNT(j)  (256  + 64 * (j))
#define XB_XSUB(j)  (1280 + 64 * (j))
#define XB_XGEN(j)  (2304 + 64 * (j))
#define XB_TOP      3328
#define XB_TOPGEN   3392
#define XCD_BAR_WORDS 3456
#define XB_SPIN_CAP (1u << 22)
__device__ __forceinline__ unsigned xb_ld(unsigned* p)              { return __hip_atomic_load(p, __ATOMIC_RELAXED, __HIP_MEMORY_SCOPE_AGENT); }
__device__ __forceinline__ unsigned xb_add(unsigned* p, unsigned v) { return __hip_atomic_fetch_add(p, v, __ATOMIC_RELAXED, __HIP_MEMORY_SCOPE_AGENT); }
__device__ __forceinline__ unsigned xb_xcc_id() { return (unsigned)__builtin_amdgcn_s_getreg((3 << 11) | 20) & 0xFu; }
#define XB_SPIN(cond, bar) do { unsigned _sp = 0; while (cond) { __builtin_amdgcn_s_sleep(1); \
    if ((++_sp & 255u) == 0u) { if (xb_ld(&(bar)[XB_TMO])) break; if (_sp > XB_SPIN_CAP) { atomicAdd(&(bar)[XB_TMO], 1u); break; } } } } while (0)
struct XcdBarrier { unsigned* bar; unsigned x; volatile LAS unsigned* st; };
__device__ __forceinline__ XcdBarrier xcd_barrier_post(unsigned* bar, volatile LAS unsigned* st) {
    XcdBarrier b; b.bar = bar; b.x = xb_xcc_id(); b.st = st;
    if (threadIdx.x == 0) (void)xb_add(&bar[XB_XCNT(b.x)], 1u);
    return b;
}
__device__ __forceinline__ void xcd_barrier_complete(unsigned* bar, unsigned x, unsigned& nloc, unsigned& nx) {
    const unsigned G = gridDim.x * gridDim.y * gridDim.z;
    unsigned sum, cnt, mine, sp = 0u;
    for (;;) {
        sum = 0u; cnt = 0u; mine = 0u;
#pragma unroll
        for (unsigned j = 0; j < 16; ++j) { const unsigned c = xb_ld(&bar[XB_XCNT(j)]); sum += c; cnt += (c > 0u) ? 1u : 0u; mine = (j == x) ? c : mine; }
        if (sum == G) break;
        __builtin_amdgcn_s_sleep(1);
        if ((++sp & 255u) == 0u) { if (xb_ld(&bar[XB_TMO])) break; if (sp > XB_SPIN_CAP) { atomicAdd(&bar[XB_TMO], 1u); break; } }
    }
    nloc = mine > 0u ? mine : 1u; nx = cnt > 0u ? cnt : 1u;
}
__device__ __forceinline__ void xcd_barrier(const XcdBarrier& b) {
    asm volatile("s_waitcnt vmcnt(0)" ::: "memory");
    __syncthreads();
    if (threadIdx.x == 0) {
        unsigned* bar = b.bar;
        __builtin_amdgcn_s_waitcnt(0);
        unsigned nloc = b.st[0], nx = b.st[1];
        if (nloc == 0u) { xcd_barrier_complete(bar, b.x, nloc, nx); b.st[0] = nloc; b.st[1] = nx; }
        const unsigned old = xb_add(&bar[XB_XSUB(b.x)], 1u);
        const unsigned gen = old / nloc;
        if (old + 1u == (gen + 1u) * nloc) {
            __builtin_amdgcn_fence(__ATOMIC_RELEASE, "agent");
            asm volatile("s_waitcnt vmcnt(0)" ::: "memory");
            const unsigned og = xb_add(&bar[XB_TOP], 1u);
            const unsigned tg = og / nx;
            if (og + 1u == (tg + 1u) * nx) xb_add(&bar[XB_TOPGEN], 1u);
            else XB_SPIN(xb_ld(&bar[XB_TOPGEN]) == tg, bar);
            __builtin_amdgcn_fence(__ATOMIC_ACQUIRE, "agent");
            xb_add(&bar[XB_XGEN(b.x)], 1u);
            asm volatile("s_waitcnt vmcnt(0)" ::: "memory");
        } else {
            XB_SPIN(xb_ld(&bar[XB_XGEN(b.x)]) == gen, bar);
            __builtin_amdgcn_fence(__ATOMIC_ACQUIRE, "agent");
            asm volatile("s_waitcnt vmcnt(0)" ::: "memory");
        }
    }
    __syncthreads();
}

#define GB_CNT(g)   (3456 + 64 * (g))
#define GB_MASK(g)  (4096 + 64 * (g))
#define BAR_ZERO_WORDS 4608
__device__ __forceinline__ void group_barrier(unsigned* bar, unsigned g, unsigned nmem) {
    asm volatile("s_waitcnt vmcnt(0)" ::: "memory");
    __syncthreads();
    if (threadIdx.x == 0) {
        __builtin_amdgcn_s_waitcnt(0);
        const unsigned old = xb_add(&bar[GB_CNT(g)], 1u);
        const unsigned target = (old / nmem + 1u) * nmem;
        XB_SPIN(xb_ld(&bar[GB_CNT(g)]) < target, bar);
        __builtin_amdgcn_fence(__ATOMIC_ACQUIRE, "agent");
        asm volatile("s_waitcnt vmcnt(0)" ::: "memory");
    }
    __syncthreads();
}

struct Args { const float* in[15]; float* out; unsigned char* ws; };

#ifndef PROBE_A2
#define PROBE_A2 0
#endif
#ifndef PROBE_B2
#define PROBE_B2 0
#endif
#ifndef PROBE_P2
#define PROBE_P2 0
#endif
#ifndef PROBE_GU2
#define PROBE_GU2 0
#endif
#ifndef PROBE_RS2
#define PROBE_RS2 0
#endif
#ifndef PROBE_PJ2
#define PROBE_PJ2 0
#endif
#ifndef PROBE_S2
#define PROBE_S2 0
#endif
constexpr int NTHREADS = 512;
constexpr int LDS_BYTES = 151552;
constexpr int RSTD_OFF = 131072 + 1024;
constexpr int MISC_OFF = 131072 + 320;

__global__ void __launch_bounds__(NTHREADS, 2) yoco_fwd(Args args) {
    extern __shared__ __attribute__((aligned(16))) unsigned char lds_raw[];
    LAS unsigned char* lds = (LAS unsigned char*)lds_raw;
    cg::grid_group grid = cg::this_grid();
    const int tid = threadIdx.x, lane = tid & 63, wave = __builtin_amdgcn_readfirstlane(tid >> 6);
    constexpr int G = 256; const int bx = blockIdx.x;
    unsigned char* ws = args.ws;
    const float* x = args.in[0]; const float* ffn_norm = args.in[1]; const float* w_gate = args.in[2]; const float* w_up = args.in[3]; const float* w_down = args.in[4];
    const float* mix_norm = args.in[5]; const float* a_w_qkv = args.in[6]; const float* a_w_o = args.in[7]; const float* a_rel_bias = args.in[8];
    const float* kv_norm = args.in[9]; const float* b_w_kvf = args.in[10]; const float* b_f_bias = args.in[11]; const float* b_w_q = args.in[12]; const float* b_w_o = args.in[13];
    const float* final_norm = args.in[14];
    float* hout = args.out;

    unsigned* barw = (unsigned*)(ws + WS_BAR);
    volatile LAS unsigned* MISC = (volatile LAS unsigned*)(lds + MISC_OFF);
    if (tid < 2) MISC[tid] = 0u;
    if (bx == 0) for (int i = tid; i < BAR_ZERO_WORDS; i += NTHREADS) __hip_atomic_store(barw + i, 0u, __ATOMIC_RELAXED, __HIP_MEMORY_SCOPE_AGENT);
    {
        LAS float* scr = (LAS float*)(lds + wave * 16384);
        float* ssq = (float*)(ws + WS_SSQ); bf16_t* hb = (bf16_t*)(ws + WS_HB);
        const int gw = bx * 8 + wave, NGW = G * 8;
        constexpr int I_G = (DM / 64) * (FF / 32), I_D = (FF / 64) * (DM / 32), I_FFN = 2 * I_G + I_D;
        constexpr int I_QKV = (DM / 64) * (3 * DM / 32), I_SQ = (DM / 64) * (DM / 32), I_KVF = (DM / 64) * 65;
        constexpr int NITEMS = 8 * I_FFN + 2 * I_QKV + 2 * I_SQ + I_KVF + 2 * I_SQ + 2 * I_SQ;
        for (int rep = 0; rep < 1 + PROBE_P2; ++rep)
        for (int it = gw; it < NITEMS; it += NGW) {
            int r = it;
            if (r < 8 * I_FFN) {
                const int idx = r / I_FFN; r -= idx * I_FFN; bf16_t* wgu = (bf16_t*)(ws + WS_W + idx * W_FFN_BLK); bf16_t* wd = (bf16_t*)(ws + WS_W + idx * W_FFN_BLK + W_GU_BYTES);
                if (r < 2 * I_G) { const int s = r / I_G; r -= s * I_G; const int nblk = FF / 32, kb = r / nblk, nb = r % nblk, n0 = nb * 32;
                    cvt_item((s ? w_up : w_gate) + (size_t)idx * DM * FF, DM, FF, ffn_norm + idx * DM, wgu, 256 * (n0 >> 7) + 128 * s + (n0 & 127), kb * 64, n0, scr, lane, true); }
                else { r -= 2 * I_G; const int nblk = DM / 32, kb = r / nblk, nb = r % nblk; cvt_item(w_down + (size_t)idx * FF * DM, FF, DM, nullptr, wd, nb * 32, kb * 64, nb * 32, scr, lane, false); }
                continue;
            }
            r -= 8 * I_FFN;
            if (r < 2 * I_QKV) { const int la = r / I_QKV; r -= la * I_QKV; const int nblk = 3 * DM / 32, kb = r / nblk, nb = r % nblk;
                cvt_item(a_w_qkv + (size_t)la * DM * 3 * DM, DM, 3 * DM, mix_norm + la * DM, (bf16_t*)(ws + WS_WQKV) + (size_t)la * 3 * DM * DM, nb * 32, kb * 64, nb * 32, scr, lane, true); continue; }
            r -= 2 * I_QKV;
            if (r < 2 * I_SQ) { const int la = r / I_SQ; r -= la * I_SQ; const int nblk = DM / 32, kb = r / nblk, nb = r % nblk;
                cvt_item(a_w_o + (size_t)la * DM * DM, DM, DM, nullptr, (bf16_t*)(ws + WS_WAO) + (size_t)la * DM * DM, nb * 32, kb * 64, nb * 32, scr, lane, false); continue; }
            r -= 2 * I_SQ;
            if (r < I_KVF) { const int nblk = 65, kb = r / nblk, nb = r % nblk;
                cvt_item(b_w_kvf, DM, 2 * DM + NH, kv_norm, (bf16_t*)(ws + WS_WKVF), nb * 32, kb * 64, nb * 32, scr, lane, true); continue; }
            r -= I_KVF;
            if (r < 2 * I_SQ) { const int lb = r / I_SQ; r -= lb * I_SQ; const int nblk = DM / 32, kb = r / nblk, nb = r % nblk;
                cvt_item(b_w_q + (size_t)lb * DM * DM, DM, DM, mix_norm + (2 + lb) * DM, (bf16_t*)(ws + WS_WBQ) + (size_t)lb * DM * DM, nb * 32, kb * 64, nb * 32, scr, lane, true); continue; }
            r -= 2 * I_SQ;
            { const int lb = r / I_SQ; r -= lb * I_SQ; const int nblk = DM / 32, kb = r / nblk, nb = r % nblk;
                cvt_item(b_w_o + (size_t)lb * DM * DM, DM, DM, nullptr, (bf16_t*)(ws + WS_WBO) + (size_t)lb * DM * DM, nb * 32, kb * 64, nb * 32, scr, lane, false); }
        }
        for (int m = gw; m < TOK; m += NGW) {
            const f32x4* xr = (const f32x4*)(x + (size_t)m * DM) + lane; f32x4 v[4]; float s = 0.f;
#pragma unroll
            for (int j = 0; j < 4; ++j) v[j] = xr[64 * j];
            u32x2* o8 = (u32x2*)(hb + (size_t)m * DM) + lane;
#pragma unroll
            for (int j = 0; j < 4; ++j) { const u32x2 w = (u32x2){pack_h2(v[j].x, v[j].y), pack_h2(v[j].z, v[j].w)}; o8[64 * j] = w;
                const float r0 = h_lo(w.x), r1 = h_hi(w.x), r2 = h_lo(w.y), r3 = h_hi(w.y); s += (r0 * r0 + r1 * r1) + (r2 * r2 + r3 * r3); }
            s = wave_sum(s);
            if (lane < 16) ssq[(size_t)m * 16 + lane] = lane == 0 ? s : 0.f;
        }
    }
    __syncthreads();
    grid.sync();
    const XcdBarrier xb = xcd_barrier_post(barw, MISC);
    const int grp = bx & 7, gj = bx >> 3; constexpr int GJ = G >> 3;
    if (tid == 0) __hip_atomic_fetch_or(barw + GB_MASK(grp), 1u << xb.x, __ATOMIC_RELAXED, __HIP_MEMORY_SCOPE_AGENT);
    bool use_group = false;

#pragma unroll 1
    for (int opi = 0; opi < 58; ++opi) {
        const int op = opi >> 1, rep = opi & 1;
        unsigned char* wsv = args.ws; asm volatile("" : "+s"(wsv));
        float* ssq = (float*)(wsv + WS_SSQ); float* flog = (float*)(wsv + WS_FLOG); float* cum = (float*)(wsv + WS_CUM);
        bf16_t* hb = (bf16_t*)(wsv + WS_HB);
        bf16_t* Rq = (bf16_t*)(wsv + WS_R + (size_t)(bx & 7) * (16 * MiB)); bf16_t* Rk = Rq + (size_t)SEQ * DM; bf16_t* Rv = Rk + (size_t)SEQ * DM;
        bf16_t* mid = (bf16_t*)(wsv + WS_R + (size_t)(bx & 7) * (2 * MiB));
        bf16_t* Ksh = (bf16_t*)(wsv + WS_KSH); bf16_t* Vsh = (bf16_t*)(wsv + WS_VSH);
        unsigned char* ws = wsv;
        int tidv = threadIdx.x; asm volatile("" : "+v"(tidv));
        int l, j;
        if (op < 14) { l = op / 7; j = op % 7; } else if (op == 14) { l = 2; j = 7; } else { l = 2 + (op - 15) / 7; j = (op - 15) % 7; }
        const bool dbl = (PROBE_GU2 && (j == 0 || j == 5)) || (PROBE_RS2 && (j == 1 || j == 6 || j == 4)) || (PROBE_PJ2 && (j == 2 || j == 7));
        if (rep == 0 && !dbl) continue;
        const int p = j >= 5 ? 1 : 0;
        const int idx = l * 2 + p;
        const LAS float* rstdL = (const LAS float*)(lds + RSTD_OFF);
        if ((j == 0 || j == 5 || j == 2 || j == 7) && op != 15) {
            const GAS float* sp = (const GAS float*)ssq + ((size_t)grp * SEQ + tidv * 8) * 16;
#pragma unroll
            for (int r = 0; r < 8; ++r) { const f32x4 a = *(const GAS f32x4*)(sp + r * 16), b2 = *(const GAS f32x4*)(sp + r * 16 + 4), c = *(const GAS f32x4*)(sp + r * 16 + 8), d = *(const GAS f32x4*)(sp + r * 16 + 12);
                const float ssum = ((a.x + a.y) + (a.z + a.w)) + ((b2.x + b2.y) + (b2.z + b2.w)) + ((c.x + c.y) + (c.z + c.w)) + ((d.x + d.y) + (d.z + d.w));
                ((LAS float*)(lds + RSTD_OFF))[tidv * 8 + r] = __builtin_amdgcn_rsqf(ssum * (1.0f / DM) + EPS); }
            __syncthreads();
        }
        if (j == 7) {
            const int ln = tidv & 63, wv = __builtin_amdgcn_readfirstlane(tidv >> 6), m16 = ln & 15, kg = ln >> 4;
            const int rowl = gj * 128 + wv * 16 + m16;
            const GAS bf16_t* ap = (const GAS bf16_t*)hb + ((size_t)grp * SEQ + rowl) * DM + 8 * kg;
            const GAS bf16_t* wp = (const GAS bf16_t*)(ws + WS_WKVF) + (size_t)(2 * DM + m16) * DM + 8 * kg;
            f32x4 fa = {0.f, 0.f, 0.f, 0.f};
#pragma unroll 8
            for (int st = 0; st < 32; ++st) {
                const bf16x8 av = *(const GAS bf16x8*)(ap + 32 * st), wv8 = *(const GAS bf16x8*)(wp + 32 * st);
                fa = __builtin_amdgcn_mfma_f32_16x16x32_f16(__builtin_bit_cast(f16x8, wv8), __builtin_bit_cast(f16x8, av), fa, 0, 0, 0);
            }
            const float rr = rstdL[rowl];
            const f32x4 bb = *(const GAS f32x4*)((const GAS float*)b_f_bias + 4 * kg); f32x4 fo;
#pragma unroll
            for (int e = 0; e < 4; ++e) { const float xx = fa[e] * rr + bb[e]; fo[e] = fminf(xx, 0.f) - 0.6931471805599453f * __builtin_amdgcn_logf(1.0f + __builtin_amdgcn_exp2f(-fabsf(xx) * LOG2E)); }
            *(GAS f32x4*)((GAS float*)flog + ((size_t)grp * SEQ + rowl) * 16 + 4 * kg) = fo;
        }
        if (j == 0 || j == 5) {
            pg8::Gemm g{hb, (const bf16_t*)(ws + WS_W + idx * W_FFN_BLK), TOK, 2 * FF, DM}; pg8::StaticOrder S; S.init(TOK, 2 * FF, G, bx);
            pg8::EpiSwiglu E{mid, rstdL, grp * SEQ};
            pg8::gemm_phase<pg8::EpiSwiglu, pg8::StaticOrder, true, true>(lds, g, S, E, tidv);
        } else if (j == 1 || j == 6 || j == 4) {
            if (op == 16 && gj < NH) {
                const int b = grp, hh = gj; const float* src = flog + ((size_t)b * SEQ + tid * 8) * 16 + hh; float v[8];
#pragma unroll
                for (int i = 0; i < 8; ++i) v[i] = src[(size_t)i * 16];
#pragma unroll
                for (int i = 1; i < 8; ++i) v[i] += v[i - 1];
                float incl = v[7];
#pragma unroll
                for (int o = 1; o < 64; o <<= 1) { const float t2 = __shfl_up(incl, o); if (lane >= o) incl += t2; }
                volatile LAS float* wtot = (volatile LAS float*)(lds + MISC_OFF + 64);
                if (lane == 63) wtot[wave] = incl;
                __syncthreads();
                float base = incl - v[7];
                for (int w = 0; w < wave; ++w) base += wtot[w];
                float* dst = cum + ((size_t)b * NH + hh) * SEQ + tid * 8;
                *(f32x4*)dst = (f32x4){base + v[0], base + v[1], base + v[2], base + v[3]}; *(f32x4*)(dst + 4) = (f32x4){base + v[4], base + v[5], base + v[6], base + v[7]};
            }
            const bool isO = (j == 4);
            const bf16_t* A = isO ? Rq : mid;
            const bf16_t* Bt = isO ? (l < 2 ? (const bf16_t*)(ws + WS_WAO) + (size_t)l * DM * DM : (const bf16_t*)(ws + WS_WBO) + (size_t)(l - 2) * DM * DM)
                                   : (const bf16_t*)(ws + WS_W + idx * W_FFN_BLK + W_GU_BYTES);
            pg8::Gemm g{A, Bt, TOK, DM, isO ? DM : FF}; pg8::StaticOrder S; S.init(TOK, DM, G, bx);
            pg8::EpiResid E{hb, ssq, (dbl && rep == 0) ? 0.0f : (isO ? 1.0f : 0.5f)};
            pg8::gemm_phase<pg8::EpiResid, pg8::StaticOrder, true, true>(lds, g, S, E, tidv);
        } else if (j == 2 || j == 7) {
            const bf16_t* Bt; int N; bf16_t* O0; long ostr; float sc; float* fl = nullptr;
            if (j == 7) { Bt = (const bf16_t*)(ws + WS_WKVF); N = 2 * DM; O0 = Ksh; ostr = (long)((WS_VSH - WS_KSH) / 2); sc = 1.0f; }
            else if (l < 2) { Bt = (const bf16_t*)(ws + WS_WQKV) + (size_t)l * 3 * DM * DM; N = 3 * DM; O0 = Rq; ostr = (long)SEQ * DM; sc = QSCALE; }
            else { Bt = (const bf16_t*)(ws + WS_WBQ) + (size_t)(l - 2) * DM * DM; N = DM; O0 = Rq; ostr = 0; sc = QSCALE; }
            pg8::Gemm g{hb, Bt, TOK, N, DM}; pg8::StaticOrder S; S.init(TOK, N, G, bx);
            pg8::EpiProj E{O0, ostr, rstdL, grp * SEQ, sc, fl, b_f_bias};
            pg8::gemm_phase<pg8::EpiProj, pg8::StaticOrder, true, true>(lds, g, S, E, tidv);
        } else {
            if (l < 2) {
                for (int v = gj; v < NH * 16; v += GJ) { const int hh = v & 15, qb = v >> 4;
                    if (PROBE_A2) att::attn_unit<0>(lds, Rq, Rk, Rv, Vsh, a_rel_bias + (size_t)l * NH * NREL, grp, hh, qb, tidv);
                    att::attn_unit<0>(lds, Rq, Rk, Rv, Rq, a_rel_bias + (size_t)l * NH * NREL, grp, hh, qb, tidv); }
            } else {
                for (int i = 0; i < 8; ++i) { const int hh = 4 * (gj >> 3) + (i >> 1), sidx = gj & 7, qb = (i & 1) ? 15 - sidx : sidx;
                    if (PROBE_B2) att::attn_unit<1>(lds, Rq, Ksh, Vsh, Rk, cum, grp, hh, qb, tidv);
                    att::attn_unit<1>(lds, Rq, Ksh, Vsh, Rq, cum, grp, hh, qb, tidv); }
            }
        }
        if (op != 14) {
            if (use_group && op != 13) group_barrier(barw, (unsigned)grp, (unsigned)GJ);
            else { xcd_barrier(xb);
                if (op == 0) {
                    bool ok = true;
#pragma unroll
                    for (int g = 0; g < 8; ++g) { const unsigned mk = xb_ld(barw + GB_MASK(g)); ok = ok && (mk != 0u) && ((mk & (mk - 1u)) == 0u); }
                    use_group = ok && !PROBE_S2; } }
        }
    }

    {
        const bf16_t* hb = (const bf16_t*)(ws + WS_HB);
        for (int r = gj * 8 + wave; r < SEQ; r += GJ * 8) { const int m = grp * SEQ + r;
            const u32x2* hr = (const u32x2*)(hb + (size_t)m * DM) + lane; f32x4* xr = (f32x4*)(hout + (size_t)m * DM) + lane; const f32x4* gr = (const f32x4*)final_norm + lane; f32x4 v[4]; float s = 0.f;
#pragma unroll
            for (int jj = 0; jj < 4; ++jj) { const u32x2 w = hr[64 * jj]; v[jj] = (f32x4){h_lo(w.x), h_hi(w.x), h_lo(w.y), h_hi(w.y)}; s += (v[jj].x * v[jj].x + v[jj].y * v[jj].y) + (v[jj].z * v[jj].z + v[jj].w * v[jj].w); }
            const float rs = rsqrtf(wave_sum(s) * (1.0f / DM) + EPS);
#pragma unroll
            for (int jj = 0; jj < 4; ++jj) __builtin_nontemporal_store(v[jj] * rs * gr[64 * jj], xr + 64 * jj);
        }
    }
}

extern "C" void kernel_launch(void* const* d_in, const int* in_sizes, int n_in, void* d_out, int out_size, void* d_ws, size_t ws_size, hipStream_t stream) {
    static int grid = 0;
    if (grid == 0) {
        if (n_in != 15 || out_size != TOK * DM || ws_size < WS_END) { fprintf(stderr, "kernel_launch: unexpected shapes (n_in %d out %d ws %zu)\n", n_in, out_size, ws_size); grid = -1; return; }
        int dev = 0, cus = 0, per_cu = 0;
        hipGetDevice(&dev); hipDeviceGetAttribute(&cus, hipDeviceAttributeMultiprocessorCount, dev);
        if (hipFuncSetAttribute((const void*)yoco_fwd, hipFuncAttributeMaxDynamicSharedMemorySize, LDS_BYTES) != hipSuccess) { fprintf(stderr, "kernel_launch: hipFuncSetAttribute failed\n"); grid = -1; return; }
        if (hipOccupancyMaxActiveBlocksPerMultiprocessor(&per_cu, (const void*)yoco_fwd, NTHREADS, LDS_BYTES) != hipSuccess || per_cu < 1) { fprintf(stderr, "kernel_launch: occupancy query says %d\n", per_cu); per_cu = 1; }
        (void)hipGetLastError();
        if (cus < 256) fprintf(stderr, "kernel_launch: this kernel needs 256 CUs (device reports %d)\n", cus);
        grid = 256;
    }
    if (grid < 0) return;
    Args a{};
    for (int i = 0; i < 15; ++i) a.in[i] = (const float*)d_in[i];
    a.out = (float*)d_out; a.ws = (unsigned char*)d_ws;
    void* kargs[] = {&a};
    hipError_t e = hipLaunchCooperativeKernel((const void*)yoco_fwd, dim3(grid), dim3(NTHREADS), kargs, LDS_BYTES, stream);
    if (e != hipSuccess) fprintf(stderr, "cooperative launch failed: %s (grid %d)\n", hipGetErrorString(e), grid);
}
```

```cpp
#include <hip/hip_runtime.h>
#include <hip/hip_cooperative_groups.h>
#include <cstdio>
#include <cstdint>
namespace cg = cooperative_groups;

#define LAS __attribute__((address_space(3)))
typedef unsigned short bf16_t;
typedef short bf16x8 __attribute__((ext_vector_type(8)));
typedef short s16x4 __attribute__((ext_vector_type(4)));
typedef float f32x4 __attribute__((ext_vector_type(4)));
typedef float f32x16 __attribute__((ext_vector_type(16)));
typedef unsigned u32x4 __attribute__((ext_vector_type(4)));
typedef unsigned u32x2 __attribute__((ext_vector_type(2)));
typedef _Float16 f16x8 __attribute__((ext_vector_type(8)));
typedef _Float16 f16x2 __attribute__((ext_vector_type(2)));
__device__ __forceinline__ unsigned pack_h2(float a, float b) { const f16x2 v = {(_Float16)a, (_Float16)b}; return __builtin_bit_cast(unsigned, v); }
__device__ __forceinline__ float h_lo(unsigned w) { return (float)__builtin_bit_cast(f16x2, w).x; }
__device__ __forceinline__ float h_hi(unsigned w) { return (float)__builtin_bit_cast(f16x2, w).y; }

constexpr int BATCH = 8, SEQ = 4096, DM = 1024, NH = 16, HD = 64, FF = 2816, TOK = BATCH * SEQ, NREL = 513;
constexpr float EPS = 1e-6f;
constexpr float LOG2E = 1.4426950408889634f;
constexpr float QSCALE = 0.125f * LOG2E;

constexpr size_t MiB = 1u << 20;
constexpr size_t WS_SSQ = 0;
constexpr size_t WS_FLOG = 2 * MiB;
constexpr size_t WS_CUM = 4 * MiB;
constexpr size_t WS_BAR = 6 * MiB;
constexpr size_t WS_W = 8 * MiB;
constexpr size_t W_FFN_BLK = (size_t)(2 * FF * DM + DM * FF) * 2;
constexpr size_t W_GU_BYTES = (size_t)2 * FF * DM * 2;
constexpr size_t WS_WQKV = WS_W + 8 * W_FFN_BLK;
constexpr size_t WS_WAO = WS_WQKV + 2 * (size_t)3 * DM * DM * 2;
constexpr size_t WS_WKVF = WS_WAO + 2 * (size_t)DM * DM * 2;
constexpr size_t WS_WBQ = WS_WKVF + (size_t)2304 * DM * 2;
constexpr size_t WS_WBO = WS_WBQ + 2 * (size_t)DM * DM * 2;
constexpr size_t WS_WEND = WS_WBO + 2 * (size_t)DM * DM * 2;
constexpr size_t WS_HB = 169 * MiB;
constexpr size_t WS_R = 233 * MiB;
constexpr size_t WS_VSH = 425 * MiB;
constexpr size_t WS_KSH = WS_W;
constexpr size_t WS_END = 489 * MiB;
static_assert(WS_WEND <= WS_HB, "weights overflow");
static_assert(4 * W_FFN_BLK >= (size_t)TOK * DM * 2, "K_sh overlay must fit in the layer 0/1 FFN weights");
static_assert((size_t)SEQ * FF * 2 <= 24 * MiB && 3 * (size_t)SEQ * DM * 2 <= 24 * MiB && 8 * 24 * MiB <= WS_VSH - WS_R, "per-batch regions fit R");

namespace pg8 {
constexpr int BM = 256, BK = 64, HALF = 128, HTB = HALF * BK * 2, STAGE_BYTES = 8 * HTB, NXCD = 8, WGM = 4;
__host__ __device__ __forceinline__ int lds_byte(int r, int c) { const int st = (r >> 4) * 2 + (c >> 5), rr = r & 15, cc = c & 31, ob = rr * 64 + cc * 2; return st * 1024 + (ob ^ (((ob >> 9) & 1) << 5)); }
__host__ __device__ __forceinline__ void stage_rc(int b, int& R, int& C) { const int st = b / 1024, sb = b % 1024, swz = sb ^ (((sb >> 9) & 1) << 5); R = (st >> 1) * 16 + swz / 64; C = (st & 1) * 32 + (swz % 64) / 2; }
__host__ __device__ __forceinline__ int perm32(int rho) { const int n = rho >> 4, i = rho & 15; return 8 * (i >> 2) + 4 * n + (i & 3); }

struct Unit { int pm, pn; };
struct Gemm { const bf16_t* A; const bf16_t* Bt; int M, N, K; };

struct StaticOrder {
    int nM, nN, nwg, G, c;
    __host__ __device__ void init(int M, int N, int G_, int c_) { nM = M / BM; nN = N / BM; nwg = nM * nN; G = G_; c = c_; }
    __host__ __device__ bool next(int i, Unit& u) const {
        const long L = (long)i * G + c; if (L >= nwg) return false;
        int wgid = (int)L; { const int q = nwg / NXCD, r = nwg % NXCD, xcd = wgid % NXCD, off = wgid / NXCD; wgid = (xcd < r ? xcd * (q + 1) : r * (q + 1) + (xcd - r) * q) + off; }
        const int nig = WGM * nN, gid = wgid / nig, fm = gid * WGM, gsz = (nM - fm) < WGM ? (nM - fm) : WGM;
        u.pm = fm + ((wgid % nig) % gsz); u.pn = (wgid % nig) / gsz; return true;
    }
    __device__ __forceinline__ void a_ready(const Unit&) const {}
    __device__ __forceinline__ void done(const Unit&) const {}
};

__device__ __forceinline__ unsigned cvt_pk_bf16(float lo, float hi) { unsigned r; asm volatile("v_cvt_pk_bf16_f32 %0, %1, %2" : "=v"(r) : "v"(lo), "v"(hi)); return r; }

__device__ __forceinline__ float fq_sum(float v) {
    auto a = __builtin_amdgcn_permlane16_swap(__float_as_uint(v), __float_as_uint(v), false, false); v = __uint_as_float(a[0]) + __uint_as_float(a[1]);
    auto b = __builtin_amdgcn_permlane32_swap(__float_as_uint(v), __float_as_uint(v), false, false); return __uint_as_float(b[0]) + __uint_as_float(b[1]);
}
#define GAS __attribute__((address_space(1)))
__device__ __forceinline__ float fmul_s(float a, float b) { float r; asm("v_mul_f32_e32 %0, %1, %2" : "=v"(r) : "v"(a), "v"(b)); return r; }
__device__ __forceinline__ float row_rstd(const GAS float* ssq, int row, int fq) {
    const f32x4 pp = *(const GAS f32x4*)(ssq + (size_t)row * 16 + 4 * fq);
    const float s = fq_sum((pp.x + pp.y) + (pp.z + pp.w));
    return __builtin_amdgcn_rsqf(s * (1.0f / DM) + EPS);
}

struct EpiSwiglu {
    static constexpr bool PERM = true, AFTER_DRAIN = false, F16 = true;
    bf16_t* O; const LAS float* rstd; int rowbase;
    __device__ __forceinline__ void operator()(const f32x4 (&acc)[2][2][4][2], const Unit& u, int wr, int wc, int fr, int fq) const {
        const int row0 = u.pm * BM + wr * 64 + fr, col0 = u.pn * HALF + wc * 32 + 8 * fq;
        GAS bf16_t* O_g = (GAS bf16_t*)O;
        float rs[8];
#pragma unroll
        for (int i = 0; i < 8; ++i) rs[i] = rstd[row0 + (i >> 2) * HALF + (i & 3) * 16 - rowbase];
#pragma unroll
        for (int ai = 0; ai < 2; ++ai)
#pragma unroll
            for (int m = 0; m < 4; ++m) {
                const int row = row0 + ai * HALF + m * 16; const float r = rs[ai * 4 + m], nrl = -r * LOG2E, rs2 = r * r;
                unsigned w[4];
#pragma unroll
                for (int n = 0; n < 2; ++n) {
                    const f32x4 g = acc[ai][0][m][n], up = acc[ai][1][m][n];
                    const f32x4 t = g * nrl; f32x4 ex, sg;
#pragma unroll
                    for (int e = 0; e < 4; ++e) ex[e] = __builtin_amdgcn_exp2f(t[e]);
                    const f32x4 d = ex + 1.0f;
#pragma unroll
                    for (int e = 0; e < 4; ++e) sg[e] = __builtin_amdgcn_rcpf(d[e]);
                    const f32x4 y = (g * up) * (sg * rs2);
                    w[2 * n] = cvt_pk_bf16(y[0], y[1]); w[2 * n + 1] = cvt_pk_bf16(y[2], y[3]);
                }
                *(GAS u32x4*)(O_g + (size_t)row * FF + col0) = (u32x4){w[0], w[1], w[2], w[3]};
            }
    }
};

__device__ __forceinline__ float bf_lo(unsigned w) { return __uint_as_float(w << 16); }
__device__ __forceinline__ float bf_hi(unsigned w) { return __uint_as_float(w & 0xffff0000u); }
struct EpiResid {
    static constexpr bool PERM = true, AFTER_DRAIN = false, F16 = false;
    bf16_t* hb; float* ssq; float alpha;
    __device__ __forceinline__ void operator()(const f32x4 (&acc)[2][2][4][2], const Unit& u, int wr, int wc, int fr, int fq) const {
        const int row0 = u.pm * BM + wr * 64 + fr, col0 = u.pn * BM + wc * 32 + 8 * fq;
        GAS bf16_t* hb_g = (GAS bf16_t*)hb; GAS float* ssq_g = (GAS float*)ssq;
        u32x4 bv[8][2];
#pragma unroll
        for (int q = 0; q < 4; ++q)
#pragma unroll
            for (int bj = 0; bj < 2; ++bj) bv[q][bj] = *(const GAS u32x4*)(hb_g + (size_t)(row0 + (q >> 2) * HALF + (q & 3) * 16) * DM + col0 + bj * HALF);
#pragma unroll
        for (int q = 0; q < 8; ++q) {
            const int ai = q >> 2, m = q & 3;
            const int row = row0 + ai * HALF + m * 16; float ss = 0.f;
#pragma unroll
            for (int bj = 0; bj < 2; ++bj) {
                const size_t off = (size_t)row * DM + col0 + bj * HALF;
                const u32x4 b = bv[q][bj];
                const f32x4 a0 = acc[ai][bj][m][0], a1 = acc[ai][bj][m][1];
                u32x4 o;
                o.x = pack_h2(h_lo(b.x) + a0[0], h_hi(b.x) + a0[1]); o.y = pack_h2(h_lo(b.y) + a0[2], h_hi(b.y) + a0[3]);
                o.z = pack_h2(h_lo(b.z) + a1[0], h_hi(b.z) + a1[1]); o.w = pack_h2(h_lo(b.w) + a1[2], h_hi(b.w) + a1[3]);
                *(GAS u32x4*)(hb_g + off) = o;
                const float r0 = h_lo(o.x), r1 = h_hi(o.x), r2 = h_lo(o.y), r3 = h_hi(o.y), r4 = h_lo(o.z), r5 = h_hi(o.z), r6 = h_lo(o.w), r7 = h_hi(o.w);
                ss += (r0 * r0 + r1 * r1) + (r2 * r2 + r3 * r3) + (r4 * r4 + r5 * r5) + (r6 * r6 + r7 * r7);
            }
            if (q + 4 < 8) {
#pragma unroll
                for (int bj = 0; bj < 2; ++bj) bv[q + 4][bj] = *(const GAS u32x4*)(hb_g + (size_t)(row0 + ((q + 4) >> 2) * HALF + ((q + 4) & 3) * 16) * DM + col0 + bj * HALF);
            }
            ss = fq_sum(ss);
            if (fq == 0) ssq_g[(size_t)row * 16 + u.pn * 4 + wc] = ss;
        }
    }
};

struct EpiProj {
    static constexpr bool PERM = true, AFTER_DRAIN = false, F16 = true;
    bf16_t* O0; long ostride; const LAS float* rstd; int rowbase; float scale0; float* flog; const float* bf;
    __device__ __forceinline__ void operator()(const f32x4 (&acc)[2][2][4][2], const Unit& u, int wr, int wc, int fr, int fq) const {
        const int row0 = u.pm * BM + wr * 64 + fr; const int t = u.pn >> 2, pnl = u.pn & 3;
        float rs[8];
#pragma unroll
        for (int i = 0; i < 8; ++i) rs[i] = rstd[row0 + (i >> 2) * HALF + (i & 3) * 16 - rowbase];
        if (t == 2 && flog) {
            GAS float* flog_g = (GAS float*)flog; const GAS float* bf_g = (const GAS float*)bf;
            if (wc == 0 && fq < 2) {
                const f32x4 b0 = *(const GAS f32x4*)(bf_g + 8 * fq), b1 = *(const GAS f32x4*)(bf_g + 8 * fq + 4);
#pragma unroll
                for (int ai = 0; ai < 2; ++ai)
#pragma unroll
                    for (int m = 0; m < 4; ++m) {
                        const int row = row0 + ai * HALF + m * 16; const float r = rs[ai * 4 + m]; f32x4 o[2];
#pragma unroll
                        for (int n = 0; n < 2; ++n)
#pragma unroll
                            for (int e = 0; e < 4; ++e) { const float x = acc[ai][0][m][n][e] * r + (n == 0 ? b0[e] : b1[e]);
                                o[n][e] = fminf(x, 0.f) - 0.6931471805599453f * __builtin_amdgcn_logf(1.0f + __builtin_amdgcn_exp2f(-fabsf(x) * LOG2E)); }
                        *(GAS f32x4*)(flog_g + (size_t)row * 16 + 8 * fq) = o[0]; *(GAS f32x4*)(flog_g + (size_t)row * 16 + 8 * fq + 4) = o[1];
                    }
            }
            return;
        }
        GAS bf16_t* O = (GAS bf16_t*)O0 + (long)t * ostride; const float sc = t == 0 ? scale0 : 1.0f;
        const int col0 = pnl * BM + wc * 32 + 8 * fq;
#pragma unroll
        for (int ai = 0; ai < 2; ++ai)
#pragma unroll
            for (int m = 0; m < 4; ++m) {
                const int row = row0 + ai * HALF + m * 16; const float r = rs[ai * 4 + m] * sc;
#pragma unroll
                for (int bj = 0; bj < 2; ++bj) {
                    const f32x4 v0 = acc[ai][bj][m][0] * r, v1 = acc[ai][bj][m][1] * r;
                    *(GAS u32x4*)(O + (size_t)row * DM + col0 + bj * HALF) = (u32x4){cvt_pk_bf16(v0[0], v0[1]), cvt_pk_bf16(v0[2], v0[3]), cvt_pk_bf16(v1[0], v1[1]), cvt_pk_bf16(v1[2], v1[3])};
                }
            }
    }
};

typedef double f64x2_t __attribute__((ext_vector_type(2)));
__device__ __forceinline__ f32x4 zero4() {
    double a, b; asm volatile("v_mov_b64 %0, 0" : "=v"(a)); asm volatile("v_mov_b64 %0, 0" : "=v"(b));
    return __builtin_bit_cast(f32x4, (f64x2_t){a, b});
}
template <class Epi, class Sched, bool ALIGN_EPI = false, bool SP2 = false>
__device__ __forceinline__ void gemm_phase(LAS unsigned char* lds, const Gemm g, const Sched& S, const Epi& E, const int tid) {
    const int wid = __builtin_amdgcn_readfirstlane(tid >> 6), lane = tid & 63, wr = wid >> 2, wc = wid & 3, fr = lane & 15, fq = lane >> 4;
    const int K = g.K, nt = K / BK;
    unsigned voffA[2], voffB[2];
#pragma unroll
    for (int i = 0; i < 2; ++i) { int R, C; stage_rc(tid * 16 + i * 8192, R, C); const int Rb = Epi::PERM ? ((R & ~31) + perm32(R & 31)) : R;
        voffA[i] = (unsigned)(R * K + C) * 2u; voffB[i] = (unsigned)(Rb * K + C) * 2u; }
    const size_t kstep = (size_t)(BK * 2);
    const size_t hstep = (size_t)HALF * K * 2;
    const size_t tstep = 2 * hstep;
    const unsigned ldsw = (unsigned)wid * 1024u;
    const int aoff = lds_byte(wr * 64 + fr, fq * 8), boff = lds_byte(wc * 32 + fr, fq * 8);
#define PG8_SA(b, h) (((b) * 2 + (h)) * HTB)
#define PG8_SB(b, h) ((4 + (b) * 2 + (h)) * HTB)
#define PG8_STAGE(bufoff, gbase, voff) do { _Pragma("unroll") for (int _i = 0; _i < 2; ++_i) \
        __builtin_amdgcn_global_load_lds((const unsigned*)((const char*)(gbase) + (voff)[_i]), (LAS unsigned*)(lds + (bufoff) + ldsw + _i * 8192), 16, 0, 0); } while (0)
#define PG8_LDA(dst, b, h) do { _Pragma("unroll") for (int m = 0; m < 4; ++m) _Pragma("unroll") for (int k = 0; k < 2; ++k) dst[m][k] = *(const LAS bf16x8*)(lds + PG8_SA(b, h) + aoff + m * 2048 + k * 1024); } while (0)
#define PG8_LDB(dst, b, h) do { _Pragma("unroll") for (int n = 0; n < 2; ++n) _Pragma("unroll") for (int k = 0; k < 2; ++k) dst[n][k] = *(const LAS bf16x8*)(lds + PG8_SB(b, h) + boff + n * 2048 + k * 1024); } while (0)
#define PG8_MMA(ai, bj, At, Bt) do { __builtin_amdgcn_s_setprio(1); _Pragma("unroll") for (int m = 0; m < 4; ++m) _Pragma("unroll") for (int n = 0; n < 2; ++n) _Pragma("unroll") for (int k = 0; k < 2; ++k) \
        { if constexpr (Epi::F16) acc[ai][bj][m][n] = __builtin_amdgcn_mfma_f32_16x16x32_f16(__builtin_bit_cast(f16x8, Bt[n][k]), __builtin_bit_cast(f16x8, At[m][k]), acc[ai][bj][m][n], 0, 0, 0); \
          else acc[ai][bj][m][n] = __builtin_amdgcn_mfma_f32_16x16x32_bf16(Bt[n][k], At[m][k], acc[ai][bj][m][n], 0, 0, 0); } __builtin_amdgcn_s_setprio(0); } while (0)
#define PG8_WAIT_V(n) asm volatile("s_waitcnt vmcnt(" #n ")" ::: "memory")
#define PG8_WAIT_L(n) asm volatile("s_waitcnt lgkmcnt(" #n ")" ::: "memory")
#define PG8_BAR __builtin_amdgcn_s_barrier()
#define PG8_SCHED __builtin_amdgcn_sched_barrier(0)
    Unit cur, nxt; int ui = 0;
    if (!S.next(0, cur)) return;
    f32x4 acc[2][2][4][2];
#pragma unroll
    for (int a = 0; a < 2; ++a)
#pragma unroll
        for (int b = 0; b < 2; ++b)
#pragma unroll
            for (int m = 0; m < 4; ++m)
#pragma unroll
                for (int n = 0; n < 2; ++n) acc[a][b][m][n] = zero4();
    bf16x8 At[4][2], B0[2][2], B1[2][2];
    const char* cA = (const char*)g.A + (size_t)cur.pm * tstep; const char* cB = (const char*)g.Bt + (size_t)cur.pn * tstep;
    S.a_ready(cur);
    if constexpr (SP2) {
        PG8_STAGE(PG8_SB(0, 0), cB, voffB); PG8_STAGE(PG8_SB(0, 1), cB + hstep, voffB); PG8_STAGE(PG8_SA(0, 0), cA, voffA); PG8_STAGE(PG8_SA(0, 1), cA + hstep, voffA);
        if (wr == 1) PG8_BAR;
        PG8_WAIT_V(2); PG8_BAR;
        PG8_STAGE(PG8_SB(1, 0), cB + kstep, voffB); PG8_STAGE(PG8_SA(1, 0), cA + kstep, voffA); PG8_STAGE(PG8_SB(1, 1), cB + hstep + kstep, voffB);
        PG8_WAIT_V(6); PG8_BAR;
    } else {
        PG8_STAGE(PG8_SB(0, 0), cB, voffB); PG8_STAGE(PG8_SA(0, 0), cA, voffA); PG8_STAGE(PG8_SB(0, 1), cB + hstep, voffB); PG8_STAGE(PG8_SA(0, 1), cA + hstep, voffA);
        if (wr == 1) PG8_BAR;
        PG8_WAIT_V(4); PG8_BAR;
        PG8_STAGE(PG8_SB(1, 0), cB + kstep, voffB); PG8_STAGE(PG8_SA(1, 0), cA + kstep, voffA); PG8_STAGE(PG8_SB(1, 1), cB + hstep + kstep, voffB);
        PG8_WAIT_V(6); PG8_BAR;
    }
    for (;;) {
        const bool has_next = S.next(ui + 1, nxt);
        const char* nA = has_next ? (const char*)g.A + (size_t)nxt.pm * tstep : cA; const char* nB = has_next ? (const char*)g.Bt + (size_t)nxt.pn * tstep : cB;
        for (int t = 0; t < nt; t += 2) {
            const bool last = (t == nt - 2);
            const char* a1 = cA + (size_t)(t + 1) * kstep;
            const char* a2 = last ? nA : cA + (size_t)(t + 2) * kstep; const char* b2 = last ? nB : cB + (size_t)(t + 2) * kstep;
            const char* a3 = a2 + kstep; const char* b3 = b2 + kstep;
            if (last && has_next) S.a_ready(nxt);
            if constexpr (SP2) {
            PG8_LDB(B0, 0, 0); PG8_LDB(B1, 0, 1); PG8_SCHED; PG8_LDA(At, 0, 0); PG8_STAGE(PG8_SA(1, 1), a1 + hstep, voffA);
            PG8_WAIT_V(8); PG8_WAIT_L(0); PG8_BAR; PG8_MMA(0, 0, At, B0); PG8_MMA(0, 1, At, B1); PG8_BAR; PG8_SCHED;
            PG8_LDA(At, 0, 1); PG8_STAGE(PG8_SB(0, 0), b2, voffB); PG8_STAGE(PG8_SB(0, 1), b2 + hstep, voffB); PG8_STAGE(PG8_SA(0, 0), a2, voffA);
            PG8_WAIT_V(8); PG8_WAIT_L(0); PG8_BAR; PG8_MMA(1, 0, At, B0); PG8_MMA(1, 1, At, B1); PG8_BAR; PG8_SCHED;
            PG8_LDB(B0, 1, 0); PG8_LDB(B1, 1, 1); PG8_SCHED; PG8_LDA(At, 1, 0); PG8_STAGE(PG8_SA(0, 1), a2 + hstep, voffA);
            PG8_WAIT_V(8); PG8_WAIT_L(0); PG8_BAR; PG8_MMA(0, 0, At, B0); PG8_MMA(0, 1, At, B1); PG8_BAR; PG8_SCHED;
            PG8_LDA(At, 1, 1); PG8_STAGE(PG8_SB(1, 0), b3, voffB); PG8_STAGE(PG8_SB(1, 1), b3 + hstep, voffB); PG8_STAGE(PG8_SA(1, 0), a3, voffA);
            PG8_WAIT_V(8); PG8_WAIT_L(0); PG8_BAR; PG8_MMA(1, 0, At, B0); PG8_MMA(1, 1, At, B1); PG8_BAR; PG8_SCHED;
            } else {
            PG8_LDB(B0, 0, 0); PG8_SCHED; PG8_LDA(At, 0, 0); PG8_STAGE(PG8_SA(1, 1), a1 + hstep, voffA);
            PG8_WAIT_L(8); PG8_BAR; PG8_WAIT_L(0); PG8_MMA(0, 0, At, B0); PG8_BAR; PG8_SCHED;
            PG8_LDB(B1, 0, 1); PG8_STAGE(PG8_SB(0, 0), b2, voffB);
            PG8_BAR; PG8_WAIT_L(0); PG8_MMA(0, 1, At, B1); PG8_BAR;
            PG8_LDA(At, 0, 1); PG8_STAGE(PG8_SA(0, 0), a2, voffA);
            PG8_BAR; PG8_WAIT_L(0); PG8_MMA(1, 0, At, B0); PG8_BAR; PG8_SCHED;
            PG8_STAGE(PG8_SB(0, 1), b2 + hstep, voffB);
            PG8_WAIT_V(6); PG8_BAR; PG8_MMA(1, 1, At, B1); PG8_BAR;
            PG8_LDB(B0, 1, 0); PG8_SCHED; PG8_LDA(At, 1, 0); PG8_STAGE(PG8_SA(0, 1), a2 + hstep, voffA);
            PG8_WAIT_L(8); PG8_BAR; PG8_WAIT_L(0); PG8_MMA(0, 0, At, B0); PG8_BAR; PG8_SCHED;
            PG8_LDB(B1, 1, 1); PG8_STAGE(PG8_SB(1, 0), b3, voffB);
            PG8_BAR; PG8_WAIT_L(0); PG8_MMA(0, 1, At, B1); PG8_BAR;
            PG8_LDA(At, 1, 1); PG8_STAGE(PG8_SA(1, 0), a3, voffA);
            PG8_BAR; PG8_WAIT_L(0); PG8_MMA(1, 0, At, B0); PG8_BAR; PG8_SCHED;
            PG8_STAGE(PG8_SB(1, 1), b3 + hstep, voffB);
            PG8_WAIT_V(6); PG8_BAR; PG8_MMA(1, 1, At, B1); PG8_BAR;
            }
        }
        if constexpr (ALIGN_EPI) { if (wr == 0) PG8_BAR; }
        if constexpr (!Epi::AFTER_DRAIN) { E(acc, cur, wr, wc, fr, fq); S.done(cur); }
        if (!has_next) break;
#pragma unroll
        for (int a = 0; a < 2; ++a)
#pragma unroll
            for (int b = 0; b < 2; ++b)
#pragma unroll
                for (int m = 0; m < 4; ++m)
#pragma unroll
                    for (int n = 0; n < 2; ++n) acc[a][b][m][n] = zero4();
        cur = nxt; cA = nA; cB = nB; ++ui;
        if constexpr (ALIGN_EPI) { if (wr == 1) PG8_BAR; }
    }
    PG8_WAIT_V(0);
    if constexpr (!ALIGN_EPI) { if (wr == 0) PG8_BAR; }
    PG8_BAR;
#undef PG8_SA
#undef PG8_SB
#undef PG8_STAGE
#undef PG8_LDA
#undef PG8_LDB
#undef PG8_MMA
#undef PG8_WAIT_V
#undef PG8_WAIT_L
#undef PG8_BAR
#undef PG8_SCHED
}
}

namespace att {
constexpr int L_K = 0, L_V = 40960, L_KB = 81920, L_BIAS = 83200, NTAB = 639, L_END = 83200 + 2560;
__device__ __forceinline__ int crow(int r, int hi) { return (r & 3) + 8 * (r >> 2) + 4 * hi; }
__device__ __forceinline__ unsigned cvtpk(float lo, float hi) { unsigned r; asm volatile("v_cvt_pk_bf16_f32 %0, %1, %2" : "=v"(r) : "v"(lo), "v"(hi)); return r; }
typedef float f32x2_t __attribute__((ext_vector_type(2))); typedef __bf16 bf16x2_t __attribute__((ext_vector_type(2)));
__device__ __forceinline__ unsigned cvtpk_c(float lo, float hi) { const f32x2_t v = {lo, hi}; const bf16x2_t b = __builtin_convertvector(v, bf16x2_t); return __builtin_bit_cast(unsigned, b); }
__device__ __forceinline__ s16x4 vtr(LAS const unsigned char* p) { return __builtin_bit_cast(s16x4, __builtin_amdgcn_ds_read_tr16_b64_v4i16((LAS s16x4*)p)); }

__device__ __forceinline__ float fadd_s(float a, float b) { float r; asm("v_add_f32_e32 %0, %1, %2" : "=v"(r) : "v"(a), "v"(b)); return r; }
__device__ __forceinline__ float fsub_s(float a, float b) { float r; asm("v_sub_f32_e32 %0, %1, %2" : "=v"(r) : "v"(a), "v"(b)); return r; }
__device__ __forceinline__ float fadd_tr(float a, float b) { float r; asm("s_nop 0\n\tv_add_f32_e32 %0, %1, %2" : "=v"(r) : "v"(a), "v"(b)); return r; }
__device__ __forceinline__ unsigned cvtpk_tr(float lo, float hi) { unsigned r; asm volatile("s_nop 0\n\tv_cvt_pk_bf16_f32 %0, %1, %2" : "=v"(r) : "v"(lo), "v"(hi)); return r; }
__device__ __forceinline__ float fadd4_tr(float acc, float a, float b, float c, float d) {
    asm("s_nop 0\n\tv_add_f32_e32 %0, %0, %1\n\tv_add_f32_e32 %0, %0, %2\n\tv_add_f32_e32 %0, %0, %3\n\tv_add_f32_e32 %0, %0, %4" : "+v"(acc) : "v"(a), "v"(b), "v"(c), "v"(d)); return acc; }
__device__ __forceinline__ void cvtpk2_tr(unsigned& r0, unsigned& r1, float a, float b, float c, float d) {
    asm volatile("s_nop 0\n\tv_cvt_pk_bf16_f32 %0, %2, %3\n\tv_cvt_pk_bf16_f32 %1, %4, %5" : "=&v"(r0), "=&v"(r1) : "v"(a), "v"(b), "v"(c), "v"(d)); }
__device__ __forceinline__ float xhalf_max(float v) { auto rr = __builtin_amdgcn_permlane32_swap(__float_as_uint(v), __float_as_uint(v), false, false); return fmaxf(__uint_as_float(rr[0]), __uint_as_float(rr[1])); }
__device__ __forceinline__ float xhalf_sum(float v) { auto rr = __builtin_amdgcn_permlane32_swap(__float_as_uint(v), __float_as_uint(v), false, false); return __uint_as_float(rr[0]) + __uint_as_float(rr[1]); }
__device__ __forceinline__ float ffma_s(float a, float b, float c) { float r; asm("v_fma_f32 %0, %1, %2, %3" : "=v"(r) : "v"(a), "v"(b), "v"(c)); return r; }
__device__ __forceinline__ void glds16(const void* gsrc, unsigned lds_dst) { unsigned keep;
    asm volatile("s_mov_b32 %0, m0\n\ts_mov_b32 m0, %2\n\ts_nop 0\n\tglobal_load_lds_dwordx4 %1, off\n\ts_mov_b32 m0, %0" : "=&s"(keep) : "v"(gsrc), "s"(lds_dst) : "memory"); }
__device__ __forceinline__ void glds4(const void* gsrc, unsigned lds_dst) { unsigned keep;
    asm volatile("s_mov_b32 %0, m0\n\ts_mov_b32 m0, %2\n\ts_nop 0\n\tglobal_load_lds_dword %1, off\n\ts_mov_b32 m0, %0" : "=&s"(keep) : "v"(gsrc), "s"(lds_dst) : "memory"); }
template <int MODE>
__device__ __forceinline__ void attn_unit(LAS unsigned char* lds, const bf16_t* Q, const bf16_t* K, const bf16_t* V, bf16_t* O, const float* aux, int b, int h, int qb, const int tid) {
    const int lane = tid & 63, wid = __builtin_amdgcn_readfirstlane(tid >> 6), r32 = lane & 31, hi = lane >> 5;
    const size_t rowbase = (size_t)b * SEQ; const int q0 = qb * 256;
    const int t_begin = MODE == 0 ? (4 * qb - 8 > 0 ? 4 * qb - 8 : 0) : 0, t_end = 4 * qb + 4, nt = t_end - t_begin;
    const int cq = 4 * qb + (wid >> 1);
    const int w_lo = MODE == 0 ? cq - 8 : 0, w_hi = cq;
    asm volatile("s_waitcnt vmcnt(0)" ::: "memory");
    const bf16_t* ksrc = K + (rowbase + lane) * DM + h * HD + wid * 8;
    const bf16_t* vsrc = V + (rowbase + 16 * (wid & 3) + (lane >> 2)) * DM + h * HD + (wid >> 2) * 32 + (lane & 3) * 8;
    const float* cum = aux + ((size_t)b * NH + h) * SEQ;
    LAS float* biasL = (LAS float*)(lds + L_BIAS);
    if (MODE == 0) { const float* tab = aux + (size_t)h * NREL; for (int i = tid; i < NTAB; i += 512) { int rel = i - 63; rel = rel < -256 ? -256 : (rel > 256 ? 256 : rel); biasL[i] = tab[rel + 256] * LOG2E; } }
    bf16x8 qr[4];
    { const bf16_t* Qw = Q + (rowbase + q0 + wid * 32 + r32) * DM + h * HD + hi * 8;
#pragma unroll
      for (int s = 0; s < 4; ++s) qr[s] = *(const bf16x8*)(Qw + s * 16); }
    float beta = 0.f;
    if (MODE == 1) beta = __builtin_bit_cast(float, __builtin_amdgcn_readfirstlane(__builtin_bit_cast(int, cum[q0 + 32 * wid + 31] * (-LOG2E))));
    const unsigned lds0 = (unsigned)(uintptr_t)lds;
    const unsigned kdst = lds0 + L_K + wid * 1024, vdst = lds0 + L_V + wid * 1024, bdst = lds0 + L_KB;
    const bool w0 = (MODE == 1) && (wid == 0);
#define ATT_DMA(tt, slot) do { glds16(ksrc + (size_t)(tt) * 64 * DM, (unsigned)__builtin_amdgcn_readfirstlane(kdst + (slot) * 8192)); \
        glds16(vsrc + (size_t)(tt) * 64 * DM, (unsigned)__builtin_amdgcn_readfirstlane(vdst + (slot) * 8192)); \
        if (w0) glds4(cum + (tt) * 64 + lane, (unsigned)__builtin_amdgcn_readfirstlane(bdst + (slot) * 256)); } while (0)
#define ATT_WAITB(n) do { const int n_ = (n); \
        if (w0) { if (n_ >= 2) asm volatile("s_waitcnt vmcnt(6) lgkmcnt(0)\n\ts_barrier" ::: "memory"); else if (n_ == 1) asm volatile("s_waitcnt vmcnt(3) lgkmcnt(0)\n\ts_barrier" ::: "memory"); else asm volatile("s_waitcnt vmcnt(0) lgkmcnt(0)\n\ts_barrier" ::: "memory"); } \
        else    { if (n_ >= 2) asm volatile("s_waitcnt vmcnt(4) lgkmcnt(0)\n\ts_barrier" ::: "memory"); else if (n_ == 1) asm volatile("s_waitcnt vmcnt(2) lgkmcnt(0)\n\ts_barrier" ::: "memory"); else asm volatile("s_waitcnt vmcnt(0) lgkmcnt(0)\n\ts_barrier" ::: "memory"); } } while (0)
#pragma unroll
    for (int k = 0; k < 4; ++k) if (k < nt) ATT_DMA(t_begin + k, k);
    ATT_WAITB(nt - 2 > 2 ? 2 : (nt - 2 < 0 ? 0 : nt - 2));
    const unsigned kfoff = hi * 1024 + r32 * 16;
    bf16x8 kf[8];
#pragma unroll
    for (int s = 0; s < 4; ++s) { kf[2 * s] = *(LAS const bf16x8*)(lds + L_K + kfoff + s * 2048); kf[2 * s + 1] = *(LAS const bf16x8*)(lds + L_K + kfoff + s * 2048 + 512); }
    float mu = 0.f, lrun = 0.f; f32x16 o0 = {}, o1 = {};
    const int qpos = q0 + wid * 32 + r32;
    const int vlane = ((lane >> 4) & 1) * 32 + (lane & 3) * 8 + (4 * hi + ((lane & 15) >> 2)) * 64;
    constexpr float THR = 12.0f;
    int cur = 0;
    for (int i = 0; i < nt; ++i) {
        const int t = t_begin + i; const int nxt = cur == 4 ? 0 : cur + 1, s4 = cur == 0 ? 4 : cur - 1;
        if (i + 4 < nt) ATT_DMA(t + 4, s4);
        const bool act = (t >= w_lo && t <= w_hi);
        f32x16 p0, p1; s16x4 vf[16];
        if (act) {
            if (MODE == 0) {
                LAS const float* bp = biasL + (qpos - 64 * t - 4 * hi + 4);
#pragma unroll
                for (int r = 0; r < 16; ++r) { const int kvl = (r & 3) + 8 * (r >> 2); p0[r] = bp[59 - kvl]; p1[r] = bp[27 - kvl]; }
                if (__any(mu != 0.f)) {
#pragma unroll
                    for (int r = 0; r < 16; ++r) { p0[r] -= mu; p1[r] -= mu; } }
            } else {
                LAS const float* kb = (LAS const float*)(lds + L_KB + cur * 256) + 4 * hi; const float noff = -(beta + mu);
#pragma unroll
                for (int g = 0; g < 4; ++g) { const f32x4 a = *(LAS const f32x4*)(kb + 8 * g), c = *(LAS const f32x4*)(kb + 32 + 8 * g);
#pragma unroll
                    for (int e = 0; e < 4; ++e) { p0[4 * g + e] = ffma_s(a[e], -LOG2E, noff); p1[4 * g + e] = ffma_s(c[e], -LOG2E, noff); } }
            }
#pragma unroll
            for (int s = 0; s < 4; ++s) {
                p0 = __builtin_amdgcn_mfma_f32_32x32x16_bf16(kf[2 * s], qr[s], p0, 0, 0, 0);
                p1 = __builtin_amdgcn_mfma_f32_32x32x16_bf16(kf[2 * s + 1], qr[s], p1, 0, 0, 0);
            }
            LAS const unsigned char* vp = lds + L_V + cur * 8192 + vlane;
#pragma unroll
            for (int s = 0; s < 4; ++s) { vf[4 * s] = vtr(vp + s * 1024); vf[4 * s + 1] = vtr(vp + s * 1024 + 512); vf[4 * s + 2] = vtr(vp + 4096 + s * 1024); vf[4 * s + 3] = vtr(vp + 4096 + s * 1024 + 512); }
        }
        if (i + 1 < nt) {
#pragma unroll
            for (int s = 0; s < 4; ++s) { kf[2 * s] = *(LAS const bf16x8*)(lds + L_K + nxt * 8192 + kfoff + s * 2048); kf[2 * s + 1] = *(LAS const bf16x8*)(lds + L_K + nxt * 8192 + kfoff + s * 2048 + 512); }
        }
        if (act) {
            if (MODE == 1 && t == cq) {
                const int kp0 = 64 * t + 4 * hi;
#pragma unroll
                for (int r = 0; r < 16; ++r) { const int kvp = kp0 + (r & 3) + 8 * (r >> 2); if (kvp > qpos) p0[r] = -1e30f; if (kvp + 32 > qpos) p1[r] = -1e30f; }
            }
            float mt = __builtin_fmaxf(__builtin_fmaxf(p0[0], p1[0]), p0[1]);
#pragma unroll
            for (int r = 1; r < 16; ++r) { if (r > 1) mt = __builtin_fmaxf(__builtin_fmaxf(mt, p0[r]), p1[r]); else mt = __builtin_fmaxf(mt, p1[1]); }
            mt = xhalf_max(mt);
            if (__any(mt > THR)) {
                const float d = fmaxf(mt, 0.f), f = __builtin_amdgcn_exp2f(-d); mu += d; lrun *= f;
#pragma unroll
                for (int r = 0; r < 16; ++r) { p0[r] -= d; p1[r] -= d; o0[r] *= f; o1[r] *= f; }
            }
#pragma unroll
            for (int r = 0; r < 16; ++r) { p0[r] = __builtin_amdgcn_exp2f(p0[r]); p1[r] = __builtin_amdgcn_exp2f(p1[r]); }
            float ls0 = 0.f, ls1 = 0.f;
#pragma unroll
            for (int r = 0; r < 16; r += 4) { ls0 = fadd4_tr(ls0, p0[r], p0[r + 1], p0[r + 2], p0[r + 3]); ls1 = fadd4_tr(ls1, p1[r], p1[r + 1], p1[r + 2], p1[r + 3]); }
            lrun = fadd_s(lrun, fadd_s(ls0, ls1));
#pragma unroll
            for (int s = 0; s < 4; ++s) {
                u32x4 pw;
                unsigned w0_, w1_, w2_, w3_;
                if (s == 0) { cvtpk2_tr(w0_, w1_, p0[0], p0[1], p0[2], p0[3]); cvtpk2_tr(w2_, w3_, p0[4], p0[5], p0[6], p0[7]); }
                else if (s == 1) { cvtpk2_tr(w0_, w1_, p0[8], p0[9], p0[10], p0[11]); cvtpk2_tr(w2_, w3_, p0[12], p0[13], p0[14], p0[15]); }
                else if (s == 2) { cvtpk2_tr(w0_, w1_, p1[0], p1[1], p1[2], p1[3]); cvtpk2_tr(w2_, w3_, p1[4], p1[5], p1[6], p1[7]); }
                else { cvtpk2_tr(w0_, w1_, p1[8], p1[9], p1[10], p1[11]); cvtpk2_tr(w2_, w3_, p1[12], p1[13], p1[14], p1[15]); }
                pw = (u32x4){w0_, w1_, w2_, w3_};
                const bf16x8 pb = __builtin_bit_cast(bf16x8, pw);
                const s16x4 a0 = vf[4 * s], a1 = vf[4 * s + 1], c0 = vf[4 * s + 2], c1 = vf[4 * s + 3];
                const bf16x8 v0 = (bf16x8){a0[0], a0[1], a0[2], a0[3], a1[0], a1[1], a1[2], a1[3]};
                const bf16x8 v1 = (bf16x8){c0[0], c0[1], c0[2], c0[3], c1[0], c1[1], c1[2], c1[3]};
                o0 = __builtin_amdgcn_mfma_f32_32x32x16_bf16(v0, pb, o0, 0, 0, 0);
                o1 = __builtin_amdgcn_mfma_f32_32x32x16_bf16(v1, pb, o1, 0, 0, 0);
            }
        }
        { const int rem = nt - i - 3; ATT_WAITB(rem > 2 ? 2 : (rem < 0 ? 0 : rem)); }
        cur = nxt;
    }
#undef ATT_DMA
#undef ATT_WAITB
    const float ltot = fmaxf(xhalf_sum(lrun), 1e-37f); const float inv = __builtin_amdgcn_rcpf(ltot);
    unsigned ox[8], oy[8];
#pragma unroll
    for (int g = 0; g < 4; ++g) {
        ox[g] = cvtpk_c(o0[4 * g] * inv, o0[4 * g + 1] * inv); oy[g] = cvtpk_c(o0[4 * g + 2] * inv, o0[4 * g + 3] * inv);
        ox[4 + g] = cvtpk_c(o1[4 * g] * inv, o1[4 * g + 1] * inv); oy[4 + g] = cvtpk_c(o1[4 * g + 2] * inv, o1[4 * g + 3] * inv);
    }
    bf16_t* Ow = O + (rowbase + q0 + wid * 32 + r32) * DM + h * HD + 8 * hi;
#pragma unroll
    for (int k = 0; k < 8; k += 2) {
        const auto rx = __builtin_amdgcn_permlane32_swap(ox[k], ox[k + 1], false, false);
        const auto ry = __builtin_amdgcn_permlane32_swap(oy[k], oy[k + 1], false, false);
        *(u32x4*)(Ow + 8 * k) = (u32x4){rx[0], ry[0], rx[1], ry[1]};
    }
}
}

__device__ __forceinline__ float wave_sum(float v) {
#pragma unroll
    for (int o = 1; o < 64; o <<= 1) v += __shfl_xor(v, o);
    return v;
}
__device__ __forceinline__ void cvt_item(const float* W, int K, int N, const float* gain, bf16_t* WT, int drow0, int k0, int n0, LAS float* scr, int lane, bool f16, float wscale = 1.0f) {
    const int n = n0 + (lane & 31); const bool ok = n < N;
    float v[32];
    { const float* src = W + (size_t)(k0 + (lane >> 5)) * N + n;
#pragma unroll
      for (int i = 0; i < 32; ++i) v[i] = ok ? src[(size_t)(2 * i) * N] : 0.f; }
#pragma unroll
    for (int i = 0; i < 32; ++i) scr[(2 * i + (lane >> 5)) * 33 + (lane & 31)] = v[i];
    f32x4 g0 = (f32x4){1.f, 1.f, 1.f, 1.f}, g1 = g0;
    if (gain) { g0 = *(const f32x4*)(gain + k0 + 8 * (lane & 7)); g1 = *(const f32x4*)(gain + k0 + 8 * (lane & 7) + 4); }
    g0 = g0 * wscale; g1 = g1 * wscale;
    asm volatile("s_waitcnt lgkmcnt(0)" ::: "memory");
    const int c = lane & 7;
#pragma unroll
    for (int j = 0; j < 4; ++j) { const int nn = (lane >> 3) + 8 * j; const LAS float* s = scr + (8 * c) * 33 + nn;
        u32x4 o;
        const float e0 = s[0 * 33] * g0.x, e1 = s[1 * 33] * g0.y, e2 = s[2 * 33] * g0.z, e3 = s[3 * 33] * g0.w, e4 = s[4 * 33] * g1.x, e5 = s[5 * 33] * g1.y, e6 = s[6 * 33] * g1.z, e7 = s[7 * 33] * g1.w;
        if (f16) { o.x = pack_h2(e0, e1); o.y = pack_h2(e2, e3); o.z = pack_h2(e4, e5); o.w = pack_h2(e6, e7); }
        else { o.x = pg8::cvt_pk_bf16(e0, e1); o.y = pg8::cvt_pk_bf16(e2, e3); o.z = pg8::cvt_pk_bf16(e4, e5); o.w = pg8::cvt_pk_bf16(e6, e7); }
        *(u32x4*)(WT + (size_t)(drow0 + nn) * K + k0 + 8 * c) = o; }
    asm volatile("s_waitcnt lgkmcnt(0)" ::: "memory");
}

#define XB_TMO      128
#define XB_XCNT(j)  (256  + 64 * (j))
#define XB_XSUB(j)  (1280 + 64 * (j))
#define XB_XGEN(j)  (2304 + 64 * (j))
#define XB_TOP      3328
#define XB_TOPGEN   3392
#define XCD_BAR_WORDS 3456
#define XB_SPIN_CAP (1u << 22)
__device__ __forceinline__ unsigned xb_ld(unsigned* p)              { return __hip_atomic_load(p, __ATOMIC_RELAXED, __HIP_MEMORY_SCOPE_AGENT); }
__device__ __forceinline__ unsigned xb_add(unsigned* p, unsigned v) { return __hip_atomic_fetch_add(p, v, __ATOMIC_RELAXED, __HIP_MEMORY_SCOPE_AGENT); }
__device__ __forceinline__ unsigned xb_xcc_id() { return (unsigned)__builtin_amdgcn_s_getreg((3 << 11) | 20) & 0xFu; }
#define XB_SPIN(cond, bar) do { unsigned _sp = 0; while (cond) { __builtin_amdgcn_s_sleep(1); \
    if ((++_sp & 255u) == 0u) { if (xb_ld(&(bar)[XB_TMO])) break; if (_sp > XB_SPIN_CAP) { atomicAdd(&(bar)[XB_TMO], 1u); break; } } } } while (0)
struct XcdBarrier { unsigned* bar; unsigned x; volatile LAS unsigned* st; };
__device__ __forceinline__ XcdBarrier xcd_barrier_post(unsigned* bar, volatile LAS unsigned* st) {
    XcdBarrier b; b.bar = bar; b.x = xb_xcc_id(); b.st = st;
    if (threadIdx.x == 0) (void)xb_add(&bar[XB_XCNT(b.x)], 1u);
    return b;
}
__device__ __forceinline__ void xcd_barrier_complete(unsigned* bar, unsigned x, unsigned& nloc, unsigned& nx) {
    const unsigned G = gridDim.x * gridDim.y * gridDim.z;
    unsigned sum, cnt, mine, sp = 0u;
    for (;;) {
        sum = 0u; cnt = 0u; mine = 0u;
#pragma unroll
        for (unsigned j = 0; j < 16; ++j) { const unsigned c = xb_ld(&bar[XB_XCNT(j)]); sum += c; cnt += (c > 0u) ? 1u : 0u; mine = (j == x) ? c : mine; }
        if (sum == G) break;
        __builtin_amdgcn_s_sleep(1);
        if ((++sp & 255u) == 0u) { if (xb_ld(&bar[XB_TMO])) break; if (sp > XB_SPIN_CAP) { atomicAdd(&bar[XB_TMO], 1u); break; } }
    }
    nloc = mine > 0u ? mine : 1u; nx = cnt > 0u ? cnt : 1u;
}
__device__ __forceinline__ void xcd_barrier(const XcdBarrier& b) {
    asm volatile("s_waitcnt vmcnt(0)" ::: "memory");
    __syncthreads();
    if (threadIdx.x == 0) {
        unsigned* bar = b.bar;
        __builtin_amdgcn_s_waitcnt(0);
        unsigned nloc = b.st[0], nx = b.st[1];
        if (nloc == 0u) { xcd_barrier_complete(bar, b.x, nloc, nx); b.st[0] = nloc; b.st[1] = nx; }
        const unsigned old = xb_add(&bar[XB_XSUB(b.x)], 1u);
        const unsigned gen = old / nloc;
        if (old + 1u == (gen + 1u) * nloc) {
            __builtin_amdgcn_fence(__ATOMIC_RELEASE, "agent");
            asm volatile("s_waitcnt vmcnt(0)" ::: "memory");
            const unsigned og = xb_add(&bar[XB_TOP], 1u);
            const unsigned tg = og / nx;
            if (og + 1u == (tg + 1u) * nx) xb_add(&bar[XB_TOPGEN], 1u);
            else XB_SPIN(xb_ld(&bar[XB_TOPGEN]) == tg, bar);
            __builtin_amdgcn_fence(__ATOMIC_ACQUIRE, "agent");
            xb_add(&bar[XB_XGEN(b.x)], 1u);
            asm volatile("s_waitcnt vmcnt(0)" ::: "memory");
        } else {
            XB_SPIN(xb_ld(&bar[XB_XGEN(b.x)]) == gen, bar);
            __builtin_amdgcn_fence(__ATOMIC_ACQUIRE, "agent");
            asm volatile("s_waitcnt vmcnt(0)" ::: "memory");
        }
    }
    __syncthreads();
}

#define GB_CNT(g)   (3456 + 64 * (g))
#define GB_MASK(g)  (4096 + 64 * (g))
#define BAR_ZERO_WORDS 4608
__device__ __forceinline__ void group_barrier(unsigned* bar, unsigned g, unsigned nmem) {
    asm volatile("s_waitcnt vmcnt(0)" ::: "memory");
    __syncthreads();
    if (threadIdx.x == 0) {
        __builtin_amdgcn_s_waitcnt(0);
        const unsigned old = xb_add(&bar[GB_CNT(g)], 1u);
        const unsigned target = (old / nmem + 1u) * nmem;
        XB_SPIN(xb_ld(&bar[GB_CNT(g)]) < target, bar);
        __builtin_amdgcn_fence(__ATOMIC_ACQUIRE, "agent");
        asm volatile("s_waitcnt vmcnt(0)" ::: "memory");
    }
    __syncthreads();
}

struct Args { const float* in[15]; float* out; unsigned char* ws; };

#ifndef PROBE_A2
#define PROBE_A2 0
#endif
#ifndef PROBE_B2
#define PROBE_B2 0
#endif
#ifndef PROBE_P2
#define PROBE_P2 0
#endif
#ifndef PROBE_GU2
#define PROBE_GU2 0
#endif
#ifndef PROBE_RS2
#define PROBE_RS2 0
#endif
#ifndef PROBE_PJ2
#define PROBE_PJ2 0
#endif
#ifndef PROBE_S2
#define PROBE_S2 0
#endif
constexpr int NTHREADS = 512;
constexpr int LDS_BYTES = 151552;
constexpr int RSTD_OFF = 131072 + 1024;
constexpr int MISC_OFF = 131072 + 320;

__global__ void __launch_bounds__(NTHREADS, 2) yoco_fwd(Args args) {
    extern __shared__ __attribute__((aligned(16))) unsigned char lds_raw[];
    LAS unsigned char* lds = (LAS unsigned char*)lds_raw;
    cg::grid_group grid = cg::this_grid();
    const int tid = threadIdx.x, lane = tid & 63, wave = __builtin_amdgcn_readfirstlane(tid >> 6);
    constexpr int G = 256; const int bx = blockIdx.x;
    unsigned char* ws = args.ws;
    const float* x = args.in[0]; const float* ffn_norm = args.in[1]; const float* w_gate = args.in[2]; const float* w_up = args.in[3]; const float* w_down = args.in[4];
    const float* mix_norm = args.in[5]; const float* a_w_qkv = args.in[6]; const float* a_w_o = args.in[7]; const float* a_rel_bias = args.in[8];
    const float* kv_norm = args.in[9]; const float* b_w_kvf = args.in[10]; const float* b_f_bias = args.in[11]; const float* b_w_q = args.in[12]; const float* b_w_o = args.in[13];
    const float* final_norm = args.in[14];
    float* hout = args.out;

    unsigned* barw = (unsigned*)(ws + WS_BAR);
    volatile LAS unsigned* MISC = (volatile LAS unsigned*)(lds + MISC_OFF);
    if (tid < 2) MISC[tid] = 0u;
    if (bx == 0) for (int i = tid; i < BAR_ZERO_WORDS; i += NTHREADS) __hip_atomic_store(barw + i, 0u, __ATOMIC_RELAXED, __HIP_MEMORY_SCOPE_AGENT);
    {
        LAS float* scr = (LAS float*)(lds + wave * 16384);
        float* ssq = (float*)(ws + WS_SSQ); bf16_t* hb = (bf16_t*)(ws + WS_HB);
        const int gw = bx * 8 + wave, NGW = G * 8;
        constexpr int I_G = (DM / 64) * (FF / 32), I_D = (FF / 64) * (DM / 32), I_FFN = 2 * I_G + I_D;
        constexpr int I_QKV = (DM / 64) * (3 * DM / 32), I_SQ = (DM / 64) * (DM / 32), I_KVF = (DM / 64) * 65;
        constexpr int NITEMS = 8 * I_FFN + 2 * I_QKV + 2 * I_SQ + I_KVF + 2 * I_SQ + 2 * I_SQ;
        for (int rep = 0; rep < 1 + PROBE_P2; ++rep)
        for (int it = gw; it < NITEMS; it += NGW) {
            int r = it;
            if (r < 8 * I_FFN) {
                const int idx = r / I_FFN; r -= idx * I_FFN; bf16_t* wgu = (bf16_t*)(ws + WS_W + idx * W_FFN_BLK); bf16_t* wd = (bf16_t*)(ws + WS_W + idx * W_FFN_BLK + W_GU_BYTES);
                if (r < 2 * I_G) { const int s = r / I_G; r -= s * I_G; const int nblk = FF / 32, kb = r / nblk, nb = r % nblk, n0 = nb * 32;
                    cvt_item((s ? w_up : w_gate) + (size_t)idx * DM * FF, DM, FF, ffn_norm + idx * DM, wgu, 256 * (n0 >> 7) + 128 * s + (n0 & 127), kb * 64, n0, scr, lane, true); }
                else { r -= 2 * I_G; const int nblk = DM / 32, kb = r / nblk, nb = r % nblk; cvt_item(w_down + (size_t)idx * FF * DM, FF, DM, nullptr, wd, nb * 32, kb * 64, nb * 32, scr, lane, false, 0.5f); }
                continue;
            }
            r -= 8 * I_FFN;
            if (r < 2 * I_QKV) { const int la = r / I_QKV; r -= la * I_QKV; const int nblk = 3 * DM / 32, kb = r / nblk, nb = r % nblk;
                cvt_item(a_w_qkv + (size_t)la * DM * 3 * DM, DM, 3 * DM, mix_norm + la * DM, (bf16_t*)(ws + WS_WQKV) + (size_t)la * 3 * DM * DM, nb * 32, kb * 64, nb * 32, scr, lane, true); continue; }
            r -= 2 * I_QKV;
            if (r < 2 * I_SQ) { const int la = r / I_SQ; r -= la * I_SQ; const int nblk = DM / 32, kb = r / nblk, nb = r % nblk;
                cvt_item(a_w_o + (size_t)la * DM * DM, DM, DM, nullptr, (bf16_t*)(ws + WS_WAO) + (size_t)la * DM * DM, nb * 32, kb * 64, nb * 32, scr, lane, false); continue; }
            r -= 2 * I_SQ;
            if (r < I_KVF) { const int nblk = 65, kb = r / nblk, nb = r % nblk;
                cvt_item(b_w_kvf, DM, 2 * DM + NH, kv_norm, (bf16_t*)(ws + WS_WKVF), nb * 32, kb * 64, nb * 32, scr, lane, true); continue; }
            r -= I_KVF;
            if (r < 2 * I_SQ) { const int lb = r / I_SQ; r -= lb * I_SQ; const int nblk = DM / 32, kb = r / nblk, nb = r % nblk;
                cvt_item(b_w_q + (size_t)lb * DM * DM, DM, DM, mix_norm + (2 + lb) * DM, (bf16_t*)(ws + WS_WBQ) + (size_t)lb * DM * DM, nb * 32, kb * 64, nb * 32, scr, lane, true); continue; }
            r -= 2 * I_SQ;
            { const int lb = r / I_SQ; r -= lb * I_SQ; const int nblk = DM / 32, kb = r / nblk, nb = r % nblk;
                cvt_item(b_w_o + (size_t)lb * DM * DM, DM, DM, nullptr, (bf16_t*)(ws + WS_WBO) + (size_t)lb * DM * DM, nb * 32, kb * 64, nb * 32, scr, lane, false); }
        }
        for (int m = gw; m < TOK; m += NGW) {
            const f32x4* xr = (const f32x4*)(x + (size_t)m * DM) + lane; f32x4 v[4]; float s = 0.f;
#pragma unroll
            for (int j = 0; j < 4; ++j) v[j] = xr[64 * j];
            u32x2* o8 = (u32x2*)(hb + (size_t)m * DM) + lane;
#pragma unroll
            for (int j = 0; j < 4; ++j) { const u32x2 w = (u32x2){pack_h2(v[j].x, v[j].y), pack_h2(v[j].z, v[j].w)}; o8[64 * j] = w;
                const float r0 = h_lo(w.x), r1 = h_hi(w.x), r2 = h_lo(w.y), r3 = h_hi(w.y); s += (r0 * r0 + r1 * r1) + (r2 * r2 + r3 * r3); }
            s = wave_sum(s);
            if (lane < 16) ssq[(size_t)m * 16 + lane] = lane == 0 ? s : 0.f;
        }
    }
    __syncthreads();
    grid.sync();
    const XcdBarrier xb = xcd_barrier_post(barw, MISC);
    const int grp = bx & 7, gj = bx >> 3; constexpr int GJ = G >> 3;
    if (tid == 0) __hip_atomic_fetch_or(barw + GB_MASK(grp), 1u << xb.x, __ATOMIC_RELAXED, __HIP_MEMORY_SCOPE_AGENT);
    bool use_group = false;

#pragma unroll 1
    for (int opi = 0; opi < 58; ++opi) {
        const int op = opi >> 1, rep = opi & 1;
        unsigned char* wsv = args.ws; asm volatile("" : "+s"(wsv));
        float* ssq = (float*)(wsv + WS_SSQ); float* flog = (float*)(wsv + WS_FLOG); float* cum = (float*)(wsv + WS_CUM);
        bf16_t* hb = (bf16_t*)(wsv + WS_HB);
        bf16_t* Rq = (bf16_t*)(wsv + WS_R + (size_t)(bx & 7) * (16 * MiB)); bf16_t* Rk = Rq + (size_t)SEQ * DM; bf16_t* Rv = Rk + (size_t)SEQ * DM;
        bf16_t* mid = (bf16_t*)(wsv + WS_R + (size_t)(bx & 7) * (2 * MiB));
        bf16_t* Ksh = (bf16_t*)(wsv + WS_KSH); bf16_t* Vsh = (bf16_t*)(wsv + WS_VSH);
        unsigned char* ws = wsv;
        int tidv = threadIdx.x; asm volatile("" : "+v"(tidv));
        int l, j;
        if (op < 14) { l = op / 7; j = op % 7; } else if (op == 14) { l = 2; j = 7; } else { l = 2 + (op - 15) / 7; j = (op - 15) % 7; }
        const bool dbl = (PROBE_GU2 && (j == 0 || j == 5)) || (PROBE_RS2 && (j == 1 || j == 6 || j == 4)) || (PROBE_PJ2 && (j == 2 || j == 7));
        if (rep == 0 && !dbl) continue;
        const int p = j >= 5 ? 1 : 0;
        const int idx = l * 2 + p;
        const LAS float* rstdL = (const LAS float*)(lds + RSTD_OFF);
        if ((j == 0 || j == 5 || j == 2 || j == 7) && op != 15) {
            const GAS float* sp = (const GAS float*)ssq + ((size_t)grp * SEQ + tidv * 8) * 16;
#pragma unroll
            for (int r = 0; r < 8; ++r) { const f32x4 a = *(const GAS f32x4*)(sp + r * 16), b2 = *(const GAS f32x4*)(sp + r * 16 + 4), c = *(const GAS f32x4*)(sp + r * 16 + 8), d = *(const GAS f32x4*)(sp + r * 16 + 12);
                const float ssum = ((a.x + a.y) + (a.z + a.w)) + ((b2.x + b2.y) + (b2.z + b2.w)) + ((c.x + c.y) + (c.z + c.w)) + ((d.x + d.y) + (d.z + d.w));
                ((LAS float*)(lds + RSTD_OFF))[tidv * 8 + r] = __builtin_amdgcn_rsqf(ssum * (1.0f / DM) + EPS); }
            __syncthreads();
        }
        if (j == 7) {
            const int ln = tidv & 63, wv = __builtin_amdgcn_readfirstlane(tidv >> 6), m16 = ln & 15, kg = ln >> 4;
            const int rowl = gj * 128 + wv * 16 + m16;
            const GAS bf16_t* ap = (const GAS bf16_t*)hb + ((size_t)grp * SEQ + rowl) * DM + 8 * kg;
            const GAS bf16_t* wp = (const GAS bf16_t*)(ws + WS_WKVF) + (size_t)(2 * DM + m16) * DM + 8 * kg;
            f32x4 fa = {0.f, 0.f, 0.f, 0.f};
#pragma unroll 8
            for (int st = 0; st < 32; ++st) {
                const bf16x8 av = *(const GAS bf16x8*)(ap + 32 * st), wv8 = *(const GAS bf16x8*)(wp + 32 * st);
                fa = __builtin_amdgcn_mfma_f32_16x16x32_f16(__builtin_bit_cast(f16x8, wv8), __builtin_bit_cast(f16x8, av), fa, 0, 0, 0);
            }
            const float rr = rstdL[rowl];
            const f32x4 bb = *(const GAS f32x4*)((const GAS float*)b_f_bias + 4 * kg); f32x4 fo;
#pragma unroll
            for (int e = 0; e < 4; ++e) { const float xx = fa[e] * rr + bb[e]; fo[e] = fminf(xx, 0.f) - 0.6931471805599453f * __builtin_amdgcn_logf(1.0f + __builtin_amdgcn_exp2f(-fabsf(xx) * LOG2E)); }
            *(GAS f32x4*)((GAS float*)flog + ((size_t)grp * SEQ + rowl) * 16 + 4 * kg) = fo;
        }
        if (j == 0 || j == 5) {
            pg8::Gemm g{hb, (const bf16_t*)(ws + WS_W + idx * W_FFN_BLK), TOK, 2 * FF, DM}; pg8::StaticOrder S; S.init(TOK, 2 * FF, G, bx);
            pg8::EpiSwiglu E{mid, rstdL, grp * SEQ};
            pg8::gemm_phase<pg8::EpiSwiglu, pg8::StaticOrder, true, true>(lds, g, S, E, tidv);
        } else if (j == 1 || j == 6 || j == 4) {
            if (op == 16 && gj < NH) {
                const int b = grp, hh = gj; const float* src = flog + ((size_t)b * SEQ + tid * 8) * 16 + hh; float v[8];
#pragma unroll
                for (int i = 0; i < 8; ++i) v[i] = src[(size_t)i * 16];
#pragma unroll
                for (int i = 1; i < 8; ++i) v[i] += v[i - 1];
                float incl = v[7];
#pragma unroll
                for (int o = 1; o < 64; o <<= 1) { const float t2 = __shfl_up(incl, o); if (lane >= o) incl += t2; }
                volatile LAS float* wtot = (volatile LAS float*)(lds + MISC_OFF + 64);
                if (lane == 63) wtot[wave] = incl;
                __syncthreads();
                float base = incl - v[7];
                for (int w = 0; w < wave; ++w) base += wtot[w];
                float* dst = cum + ((size_t)b * NH + hh) * SEQ + tid * 8;
                *(f32x4*)dst = (f32x4){base + v[0], base + v[1], base + v[2], base + v[3]}; *(f32x4*)(dst + 4) = (f32x4){base + v[4], base + v[5], base + v[6], base + v[7]};
            }
            const bool isO = (j == 4);
            const bf16_t* A = isO ? Rq : mid;
            const bf16_t* Bt = isO ? (l < 2 ? (const bf16_t*)(ws + WS_WAO) + (size_t)l * DM * DM : (const bf16_t*)(ws + WS_WBO) + (size_t)(l - 2) * DM * DM)
                                   : (const bf16_t*)(ws + WS_W + idx * W_FFN_BLK + W_GU_BYTES);
            pg8::Gemm g{A, Bt, TOK, DM, isO ? DM : FF}; pg8::StaticOrder S; S.init(TOK, DM, G, bx);
            pg8::EpiResid E{hb, ssq, (dbl && rep == 0) ? 0.0f : (isO ? 1.0f : 0.5f)};
            pg8::gemm_phase<pg8::EpiResid, pg8::StaticOrder, true, true>(lds, g, S, E, tidv);
        } else if (j == 2 || j == 7) {
            const bf16_t* Bt; int N; bf16_t* O0; long ostr; float sc; float* fl = nullptr;
            if (j == 7) { Bt = (const bf16_t*)(ws + WS_WKVF); N = 2 * DM; O0 = Ksh; ostr = (long)((WS_VSH - WS_KSH) / 2); sc = 1.0f; }
            else if (l < 2) { Bt = (const bf16_t*)(ws + WS_WQKV) + (size_t)l * 3 * DM * DM; N = 3 * DM; O0 = Rq; ostr = (long)SEQ * DM; sc = QSCALE; }
            else { Bt = (const bf16_t*)(ws + WS_WBQ) + (size_t)(l - 2) * DM * DM; N = DM; O0 = Rq; ostr = 0; sc = QSCALE; }
            pg8::Gemm g{hb, Bt, TOK, N, DM}; pg8::StaticOrder S; S.init(TOK, N, G, bx);
            pg8::EpiProj E{O0, ostr, rstdL, grp * SEQ, sc, fl, b_f_bias};
            pg8::gemm_phase<pg8::EpiProj, pg8::StaticOrder, true, true>(lds, g, S, E, tidv);
        } else {
            if (l < 2) {
                for (int v = gj; v < NH * 16; v += GJ) { const int hh = v & 15, qb = v >> 4;
                    if (PROBE_A2) att::attn_unit<0>(lds, Rq, Rk, Rv, Vsh, a_rel_bias + (size_t)l * NH * NREL, grp, hh, qb, tidv);
                    att::attn_unit<0>(lds, Rq, Rk, Rv, Rq, a_rel_bias + (size_t)l * NH * NREL, grp, hh, qb, tidv); }
            } else {
                for (int i = 0; i < 8; ++i) { const int hh = 4 * (gj >> 3) + (i >> 1), sidx = gj & 7, qb = (i & 1) ? 15 - sidx : sidx;
                    if (PROBE_B2) att::attn_unit<1>(lds, Rq, Ksh, Vsh, Rk, cum, grp, hh, qb, tidv);
                    att::attn_unit<1>(lds, Rq, Ksh, Vsh, Rq, cum, grp, hh, qb, tidv); }
            }
        }
        if (op != 14) {
            if (use_group && op != 13) group_barrier(barw, (unsigned)grp, (unsigned)GJ);
            else { xcd_barrier(xb);
                if (op == 0) {
                    bool ok = true;
#pragma unroll
                    for (int g = 0; g < 8; ++g) { const unsigned mk = xb_ld(barw + GB_MASK(g)); ok = ok && (mk != 0u) && ((mk & (mk - 1u)) == 0u); }
                    use_group = ok && !PROBE_S2; } }
        }
    }

    {
        const bf16_t* hb = (const bf16_t*)(ws + WS_HB);
        for (int r = gj * 8 + wave; r < SEQ; r += GJ * 8) { const int m = grp * SEQ + r;
            const u32x2* hr = (const u32x2*)(hb + (size_t)m * DM) + lane; f32x4* xr = (f32x4*)(hout + (size_t)m * DM) + lane; const f32x4* gr = (const f32x4*)final_norm + lane; f32x4 v[4]; float s = 0.f;
#pragma unroll
            for (int jj = 0; jj < 4; ++jj) { const u32x2 w = hr[64 * jj]; v[jj] = (f32x4){h_lo(w.x), h_hi(w.x), h_lo(w.y), h_hi(w.y)}; s += (v[jj].x * v[jj].x + v[jj].y * v[jj].y) + (v[jj].z * v[jj].z + v[jj].w * v[jj].w); }
            const float rs = rsqrtf(wave_sum(s) * (1.0f / DM) + EPS);
#pragma unroll
            for (int jj = 0; jj < 4; ++jj) __builtin_nontemporal_store(v[jj] * rs * gr[64 * jj], xr + 64 * jj);
        }
    }
}

extern "C" void kernel_launch(void* const* d_in, const int* in_sizes, int n_in, void* d_out, int out_size, void* d_ws, size_t ws_size, hipStream_t stream) {
    static int grid = 0;
    if (grid == 0) {
        if (n_in != 15 || out_size != TOK * DM || ws_size < WS_END) { fprintf(stderr, "kernel_launch: unexpected shapes (n_in %d out %d ws %zu)\n", n_in, out_size, ws_size); grid = -1; return; }
        int dev = 0, cus = 0, per_cu = 0;
        hipGetDevice(&dev); hipDeviceGetAttribute(&cus, hipDeviceAttributeMultiprocessorCount, dev);
        if (hipFuncSetAttribute((const void*)yoco_fwd, hipFuncAttributeMaxDynamicSharedMemorySize, LDS_BYTES) != hipSuccess) { fprintf(stderr, "kernel_launch: hipFuncSetAttribute failed\n"); grid = -1; return; }
        if (hipOccupancyMaxActiveBlocksPerMultiprocessor(&per_cu, (const void*)yoco_fwd, NTHREADS, LDS_BYTES) != hipSuccess || per_cu < 1) { fprintf(stderr, "kernel_launch: occupancy query says %d\n", per_cu); per_cu = 1; }
        (void)hipGetLastError();
        if (cus < 256) fprintf(stderr, "kernel_launch: this kernel needs 256 CUs (device reports %d)\n", cus);
        grid = 256;
    }
    if (grid < 0) return;
    Args a{};
    for (int i = 0; i < 15; ++i) a.in[i] = (const float*)d_in[i];
    a.out = (float*)d_out; a.ws = (unsigned char*)d_ws;
    void* kargs[] = {&a};
    hipError_t e = hipLaunchCooperativeKernel((const void*)yoco_fwd, dim3(grid), dim3(NTHREADS), kargs, LDS_BYTES, stream);
    if (e != hipSuccess) fprintf(stderr, "cooperative launch failed: %s (grid %d)\n", hipGetErrorString(e), grid);
}
```
